# Optimizing an MI355X kernel written in HIP

```python
import math
import jax, jax.numpy as jnp
from jax import lax
import numpy as np

D_MODEL = 1024
BATCH = 2
SEQ = 8192
DEPTH = 4

N_EVEN = (DEPTH + 1) // 2
N_ODD = DEPTH // 2
D_FF = 2816
N_MOD = 9
EPS = 1e-6

ATT_HEADS = 4
ATT_QK_DIM = 64
ATT_V_DIM = 2 * ATT_QK_DIM
QK_COLS = ATT_HEADS * 2 * ATT_QK_DIM
ATT_WIDTH = ATT_HEADS * ATT_V_DIM
Q_BLOCK = 128

POOL_WINDOWS = (2, 4, 8, 16)
POOL_GROUPS = len(POOL_WINDOWS)
POOL_WIDTH = D_MODEL // 2
POOL_GROUP_DIM = POOL_WIDTH // POOL_GROUPS

AB_IN_WIDTH = 2 * QK_COLS + ATT_WIDTH + POOL_WIDTH
MIX_WIDTH = ATT_WIDTH + POOL_WIDTH

CONV_WIDTH = D_MODEL
CONV_K = 3

kernel_name = "hybrid_diffattn_pool_shortconv_macaron_adaln"


def rmsnorm(x, g):
    xf = x.astype(jnp.float32)
    y = xf * lax.rsqrt(jnp.mean(xf * xf, axis=-1, keepdims=True) + EPS)
    return (y * g.astype(jnp.float32)).astype(x.dtype)


def modulated_norm(x, g, shift, scale):
    return rmsnorm(x, g) * (1 + scale) + shift


def swiglu(h, wg, wu, wd):
    return (jax.nn.silu(h @ wg) * (h @ wu)) @ wd


def diff_attention(q1, q2, k1, k2, v, lam):
    b, h, s, _ = q1.shape
    nb = s // Q_BLOCK
    scale = ATT_QK_DIM ** -0.5
    kpos = jnp.arange(s)

    def blocks(q):
        return q.reshape(b, h, nb, Q_BLOCK, q.shape[-1]).transpose(2, 0, 1, 3, 4)

    def one_block(args):
        qa, qb, i = args
        qpos = i * Q_BLOCK + jnp.arange(Q_BLOCK)
        mask = kpos[None, :] <= qpos[:, None]

        def probs(q, k):
            sc = jnp.einsum('bhqd,bhkd->bhqk', q, k).astype(jnp.float32) * scale
            sc = jnp.where(mask, sc, -jnp.inf)
            return jax.nn.softmax(sc, axis=-1)

        w = probs(qa, k1) - lam * probs(qb, k2)
        return jnp.einsum('bhqk,bhkd->bhqd', w.astype(v.dtype), v)

    out = lax.map(one_block, (blocks(q1), blocks(q2), jnp.arange(nb)))
    return out.transpose(1, 2, 0, 3, 4).reshape(b, h, s, v.shape[-1])


def multiscale_pool(u, pool_w, pool_scale):
    b, s, _ = u.shape
    uf = u.astype(jnp.float32).reshape(b, s, POOL_GROUPS, POOL_GROUP_DIM)
    cs = jnp.cumsum(uf, axis=1)
    t = jnp.arange(s)
    outs = []
    for g, w in enumerate(POOL_WINDOWS):
        csg = cs[:, :, g]
        lagged = jnp.pad(csg, ((0, 0), (w, 0), (0, 0)))[:, :s]
        cnt = jnp.minimum(t + 1, w).astype(jnp.float32)[None, :, None]
        outs.append((csg - lagged) / cnt - uf[:, :, g])
    d = jnp.stack(outs, axis=2)
    y = jnp.einsum('bsgc,gcd->bsgd', d, pool_w.astype(jnp.float32))
    y = y.reshape(b, s, POOL_WIDTH) * pool_scale.astype(jnp.float32)
    return y.astype(u.dtype)


def attn_pool_mixer(h, layer_idx, w_in, qk_g, lq1, lk1, lq2, lk2, subln_g, pool_w, pool_scale, w_out):
    b, s, _ = h.shape
    proj = h @ w_in
    q, k, v, u = jnp.split(proj, [QK_COLS, 2 * QK_COLS, 2 * QK_COLS + ATT_WIDTH], axis=-1)
    q = rmsnorm(q.reshape(b, s, ATT_HEADS, 2, ATT_QK_DIM), qk_g[0]).transpose(0, 2, 3, 1, 4)
    k = rmsnorm(k.reshape(b, s, ATT_HEADS, 2, ATT_QK_DIM), qk_g[1]).transpose(0, 2, 3, 1, 4)
    v = v.reshape(b, s, ATT_HEADS, ATT_V_DIM).transpose(0, 2, 1, 3)
    lam_init = 0.8 - 0.6 * math.exp(-0.3 * layer_idx)
    f32 = jnp.float32
    lam = (jnp.exp(jnp.sum(lq1.astype(f32) * lk1.astype(f32)))
           - jnp.exp(jnp.sum(lq2.astype(f32) * lk2.astype(f32))) + lam_init)
    o = diff_attention(q[:, :, 0], q[:, :, 1], k[:, :, 0], k[:, :, 1], v, lam)
    o = rmsnorm(o, subln_g) * (1 - lam_init)
    o = o.transpose(0, 2, 1, 3).reshape(b, s, ATT_WIDTH)
    p = multiscale_pool(u, pool_w, pool_scale)
    return jnp.concatenate([o, p], axis=-1) @ w_out


def short_conv_mixer(h, w_in, conv_w, w_out):
    b_gate, c_gate, xin = jnp.split(h @ w_in, 3, axis=-1)
    v = c_gate * xin
    s = v.shape[1]
    vp = jnp.pad(v, ((0, 0), (CONV_K - 1, 0), (0, 0)))
    y = conv_w[0] * vp[:, 0:s]
    for j in range(1, CONV_K):
        y = y + conv_w[j] * vp[:, j:j + s]
    return (b_gate * y) @ w_out


def setup_inputs(seed: int = 0) -> dict:
    key = jax.random.key(seed)
    ks = jax.random.split(key, 24)
    f32 = jnp.float32

    def nrm(k, shape, scale):
        return jax.random.normal(k, shape, f32) * scale

    D = D_MODEL
    return {
        "x": nrm(ks[0], (BATCH, SEQ, D), 1.0),
        "c": nrm(ks[1], (BATCH, D), 1.0),
        "norm_g": 1.0 + nrm(ks[2], (DEPTH, 3, D), 0.05),
        "w_ada": nrm(ks[3], (DEPTH, D, N_MOD * D), D ** -0.5),
        "b_ada": nrm(ks[4], (DEPTH, N_MOD * D), 0.02),
        "ffn_wg": nrm(ks[5], (DEPTH, 2, D, D_FF), D ** -0.5),
        "ffn_wu": nrm(ks[6], (DEPTH, 2, D, D_FF), D ** -0.5),
        "ffn_wd": nrm(ks[7], (DEPTH, 2, D_FF, D), D_FF ** -0.5),
        "w_in_ab": nrm(ks[8], (N_EVEN, D, AB_IN_WIDTH), D ** -0.5),
        "qk_norm_g": 1.0 + nrm(ks[9], (N_EVEN, 2, ATT_QK_DIM), 0.05),
        "lambda_q1": nrm(ks[10], (N_EVEN, ATT_QK_DIM), 0.1),
        "lambda_k1": nrm(ks[11], (N_EVEN, ATT_QK_DIM), 0.1),
        "lambda_q2": nrm(ks[12], (N_EVEN, ATT_QK_DIM), 0.1),
        "lambda_k2": nrm(ks[13], (N_EVEN, ATT_QK_DIM), 0.1),
        "subln_g": 1.0 + nrm(ks[14], (N_EVEN, ATT_V_DIM), 0.05),
        "pool_w": nrm(ks[15], (N_EVEN, POOL_GROUPS, POOL_GROUP_DIM, POOL_GROUP_DIM), POOL_GROUP_DIM ** -0.5),
        "pool_scale": 1.0 + nrm(ks[16], (N_EVEN, POOL_WIDTH), 0.1),
        "w_out_ab": nrm(ks[17], (N_EVEN, MIX_WIDTH, D), MIX_WIDTH ** -0.5),
        "w_in_c": nrm(ks[18], (N_ODD, D, 3 * CONV_WIDTH), D ** -0.5),
        "conv_w": nrm(ks[19], (N_ODD, CONV_K, CONV_WIDTH), CONV_K ** -0.5),
        "w_out_c": nrm(ks[20], (N_ODD, CONV_WIDTH, D), CONV_WIDTH ** -0.5),
    }


def reference(x, c, norm_g, w_ada, b_ada, ffn_wg, ffn_wu, ffn_wd, w_in_ab, qk_norm_g,
              lambda_q1, lambda_k1, lambda_q2, lambda_k2, subln_g, pool_w, pool_scale,
              w_out_ab, w_in_c, conv_w, w_out_c):
    b = x.shape[0]
    c_act = jax.nn.silu(c)
    for l in range(DEPTH):
        mod = (c_act @ w_ada[l] + b_ada[l]).reshape(b, N_MOD, 1, D_MODEL)
        sh1, sc1, g1, sh2, sc2, g2, sh3, sc3, g3 = [mod[:, i] for i in range(N_MOD)]
        h = modulated_norm(x, norm_g[l, 0], sh1, sc1)
        x = x + 0.5 * g1 * swiglu(h, ffn_wg[l, 0], ffn_wu[l, 0], ffn_wd[l, 0])
        h = modulated_norm(x, norm_g[l, 1], sh2, sc2)
        if l % 2 == 0:
            e = l // 2
            m = attn_pool_mixer(h, l, w_in_ab[e], qk_norm_g[e], lambda_q1[e], lambda_k1[e],
                                lambda_q2[e], lambda_k2[e], subln_g[e], pool_w[e],
                                pool_scale[e], w_out_ab[e])
        else:
            o = l // 2
            m = short_conv_mixer(h, w_in_c[o], conv_w[o], w_out_c[o])
        x = x + g2 * m
        h = modulated_norm(x, norm_g[l, 2], sh3, sc3)
        x = x + 0.5 * g3 * swiglu(h, ffn_wg[l, 1], ffn_wu[l, 1], ffn_wd[l, 1])
    return x
```

```cpp
#include <hip/hip_runtime.h>
#include <hip/hip_cooperative_groups.h>
#include <cstdio>
#include <cstdint>
namespace cg = cooperative_groups;
namespace pg8 {
#define PG8_LAS __attribute__((address_space(3)))
typedef unsigned short bf16_t;
typedef short bf16x8 __attribute__((ext_vector_type(8)));
typedef float f32x4 __attribute__((ext_vector_type(4)));
typedef unsigned u32x4 __attribute__((ext_vector_type(4)));
constexpr int BM = 256, BK = 64, HALF = 128, HTB = HALF * BK * 2  , STAGE_BYTES = 8 * HTB, NXCD = 8, WGM = 8;

__host__ __device__ __forceinline__ int lds_byte(int r, int c) { const int st = (r >> 4) * 2 + (c >> 5), rr = r & 15, cc = c & 31, ob = rr * 64 + cc * 2; return st * 1024 + (ob ^ (((ob >> 9) & 1) << 5)); }
__host__ __device__ __forceinline__ void stage_rc(int b, int& R, int& C) { const int st = b / 1024, sb = b % 1024, swz = sb ^ (((sb >> 9) & 1) << 5); R = (st >> 1) * 16 + swz / 64; C = (st & 1) * 32 + (swz % 64) / 2; }
__host__ __device__ __forceinline__ int perm32(int rho) { const int n = rho >> 4, i = rho & 15; return 8 * (i >> 2) + 4 * n + (i & 3); }

struct Unit { int pm, pn; };
struct Gemm { const bf16_t* A; const bf16_t* Bt; int M, N, K; };

struct StaticOrder {
    int nM, nN, nwg, G, c;
    __host__ __device__ void init(int M, int N, int G_, int c_) { nM = M / BM; nN = N / BM; nwg = nM * nN; G = G_; c = c_; }
    __host__ __device__ bool next(int i, Unit& u) const {
        const long L = (long)i * G + c; if (L >= nwg) return false;
        int wgid = (int)L; { const int q = nwg / NXCD, r = nwg % NXCD, xcd = wgid % NXCD, off = wgid / NXCD; wgid = (xcd < r ? xcd * (q + 1) : r * (q + 1) + (xcd - r) * q) + off; }
        const int nig = WGM * nN, gid = wgid / nig, fm = gid * WGM, gsz = (nM - fm) < WGM ? (nM - fm) : WGM;
        u.pm = fm + ((wgid % nig) % gsz); u.pn = (wgid % nig) / gsz; return true;
    }
    __device__ __forceinline__ void a_ready(const Unit&) const {}
    __device__ __forceinline__ void done(const Unit&) const {}
};

typedef float f32x2 __attribute__((ext_vector_type(2)));
typedef __bf16 bf16x2_t __attribute__((ext_vector_type(2)));
__device__ __forceinline__ unsigned cvt_pk_bf16(float lo, float hi) { f32x2 v = {lo, hi}; bf16x2_t b = __builtin_convertvector(v, bf16x2_t); return __builtin_bit_cast(unsigned, b); }
__device__ __forceinline__ float silu_f(float v) { return v * __builtin_amdgcn_rcpf(1.0f + __builtin_amdgcn_exp2f(-1.4426950408889634f * v)); }

struct EpiMix {
    static constexpr bool PERM = true, AFTER_DRAIN = false;
    bf16_t* O; int ldc; int pn0; int colbase; int act_silu;
    __device__ __forceinline__ void operator()(const f32x4 (&acc)[2][2][4][2], const Unit& u, int wr, int wc, int fr, int fq) const {
        const int row0 = u.pm * BM + wr * 64 + fr;
        if (u.pn < pn0) {
            const int col0 = u.pn * BM + wc * 32 + 8 * fq;
#pragma unroll
            for (int ai = 0; ai < 2; ++ai)
#pragma unroll
                for (int m = 0; m < 4; ++m) { bf16_t* rowp = O + (size_t)(row0 + ai * HALF + m * 16) * ldc + col0;
#pragma unroll
                    for (int bj = 0; bj < 2; ++bj) { const f32x4 v0 = acc[ai][bj][m][0], v1 = acc[ai][bj][m][1];
                        u32x4 w; w.x = cvt_pk_bf16(v0[0], v0[1]); w.y = cvt_pk_bf16(v0[2], v0[3]); w.z = cvt_pk_bf16(v1[0], v1[1]); w.w = cvt_pk_bf16(v1[2], v1[3]);
                        *(u32x4*)(rowp + bj * HALF) = w; } }
        } else {
            const int col0 = colbase + (u.pn - pn0) * HALF + wc * 32 + 8 * fq;
#pragma unroll
            for (int ai = 0; ai < 2; ++ai)
#pragma unroll
                for (int m = 0; m < 4; ++m) { bf16_t* rowp = O + (size_t)(row0 + ai * HALF + m * 16) * ldc + col0;
                    f32x4 g0 = acc[ai][0][m][0], g1 = acc[ai][0][m][1]; const f32x4 u0 = acc[ai][1][m][0], u1 = acc[ai][1][m][1];
                    if (act_silu) {
#pragma unroll
                        for (int e = 0; e < 4; ++e) { g0[e] = silu_f(g0[e]); g1[e] = silu_f(g1[e]); } }
                    g0 = g0 * u0; g1 = g1 * u1;
                    u32x4 w; w.x = cvt_pk_bf16(g0[0], g0[1]); w.y = cvt_pk_bf16(g0[2], g0[3]); w.z = cvt_pk_bf16(g1[0], g1[1]); w.w = cvt_pk_bf16(g1[2], g1[3]);
                    *(u32x4*)rowp = w; }
        }
    }
};
struct EpiRes {
    static constexpr bool PERM = false, AFTER_DRAIN = false;
    const float* base; float* out; const float* gate; float gs;
    static constexpr int gstride = 9216, rows_per_batch = 8192;
    __device__ __forceinline__ void operator()(const f32x4 (&acc)[2][2][4][2], const Unit& u, int wr, int wc, int fr, int fq) const {
        const int row0 = u.pm * BM + wr * 64 + fr, col0 = u.pn * BM + wc * 32 + 4 * fq;
        const float* gp = gate + (size_t)((u.pm * BM) / rows_per_batch) * gstride + col0;
#pragma unroll
        for (int bj = 0; bj < 2; ++bj)
#pragma unroll
            for (int n = 0; n < 2; ++n) { const f32x4 gv = *(const f32x4*)(gp + bj * HALF + n * 16) * gs;
#pragma unroll
                for (int ai = 0; ai < 2; ++ai)
#pragma unroll
                    for (int m = 0; m < 4; ++m) { const size_t off = (size_t)(row0 + ai * HALF + m * 16) * 1024 + col0 + bj * HALF + n * 16;
                        const f32x4 bs = *(const f32x4*)(base + off); *(f32x4*)(out + off) = bs + gv * acc[ai][bj][m][n]; } }
    }
};

template <class Epi, class Sched, bool ALIGN_EPI = false, bool SP2 = false>
__device__ __forceinline__ void gemm_phase(PG8_LAS unsigned char* lds, const Gemm g, const Sched& S, const Epi& E) {
    int tid_o = threadIdx.x; asm volatile("" : "+v"(tid_o));
    const int tid = tid_o, wid = __builtin_amdgcn_readfirstlane(tid >> 6), lane = tid & 63, wr = wid >> 2, wc = wid & 3, fr = lane & 15, fq = lane >> 4;
    const int K = g.K, nt = K / BK;
    unsigned voffA[2], voffB[2];
#pragma unroll
    for (int i = 0; i < 2; ++i) { int R, C; stage_rc(tid * 16 + i * 8192, R, C); const int Rb = Epi::PERM ? ((R & ~31) + perm32(R & 31)) : R;
        voffA[i] = (unsigned)(R * K + C) * 2u; voffB[i] = (unsigned)(Rb * K + C) * 2u; }
    const size_t kstep = (size_t)(BK * 2);
    const size_t hstep = (size_t)HALF * K * 2;
    const size_t tstep = 2 * hstep;
    const unsigned ldsw = (unsigned)wid * 1024u;
    const int aoff = lds_byte(wr * 64 + fr, fq * 8), boff = lds_byte(wc * 32 + fr, fq * 8);
#define PG8_SA(b, h) (((b) * 2 + (h)) * HTB)
#define PG8_SB(b, h) ((4 + (b) * 2 + (h)) * HTB)
#define PG8_STAGE(bufoff, gbase, voff) do { _Pragma("unroll") for (int _i = 0; _i < 2; ++_i) \
        __builtin_amdgcn_global_load_lds((const unsigned*)((const char*)(gbase) + (voff)[_i]), (PG8_LAS unsigned*)(lds + (bufoff) + ldsw + _i * 8192), 16, 0, 0); } while (0)
#define PG8_LDA(dst, b, h) do { _Pragma("unroll") for (int m = 0; m < 4; ++m) _Pragma("unroll") for (int k = 0; k < 2; ++k) dst[m][k] = *(const PG8_LAS bf16x8*)(lds + PG8_SA(b, h) + aoff + m * 2048 + k * 1024); } while (0)
#define PG8_LDB(dst, b, h) do { _Pragma("unroll") for (int n = 0; n < 2; ++n) _Pragma("unroll") for (int k = 0; k < 2; ++k) dst[n][k] = *(const PG8_LAS bf16x8*)(lds + PG8_SB(b, h) + boff + n * 2048 + k * 1024); } while (0)
#define PG8_MMA(ai, bj, At, Bt) do { __builtin_amdgcn_s_setprio(1); _Pragma("unroll") for (int m = 0; m < 4; ++m) _Pragma("unroll") for (int n = 0; n < 2; ++n) _Pragma("unroll") for (int k = 0; k < 2; ++k) \
        acc[ai][bj][m][n] = __builtin_amdgcn_mfma_f32_16x16x32_bf16(Bt[n][k], At[m][k], acc[ai][bj][m][n], 0, 0, 0); __builtin_amdgcn_s_setprio(0); } while (0)
#define PG8_WAIT_V(n) asm volatile("s_waitcnt vmcnt(" #n ")" ::: "memory")
#define PG8_WAIT_L(n) asm volatile("s_waitcnt lgkmcnt(" #n ")" ::: "memory")
#define PG8_BAR __builtin_amdgcn_s_barrier()
#define PG8_SCHED __builtin_amdgcn_sched_barrier(0)
    Unit cur, nxt; int ui = 0;
    if (!S.next(0, cur)) return;
    f32x4 acc[2][2][4][2];
#pragma unroll
    for (int a = 0; a < 2; ++a)
#pragma unroll
        for (int b = 0; b < 2; ++b)
#pragma unroll
            for (int m = 0; m < 4; ++m)
#pragma unroll
                for (int n = 0; n < 2; ++n) acc[a][b][m][n] = (f32x4){0.f, 0.f, 0.f, 0.f};
    bf16x8 At[4][2], B0[2][2], B1[2][2];
    const char* cA = (const char*)g.A + (size_t)cur.pm * tstep; const char* cB = (const char*)g.Bt + (size_t)cur.pn * tstep;
    S.a_ready(cur);
    if constexpr (SP2) {
        PG8_STAGE(PG8_SB(0, 0), cB, voffB); PG8_STAGE(PG8_SB(0, 1), cB + hstep, voffB); PG8_STAGE(PG8_SA(0, 0), cA, voffA); PG8_STAGE(PG8_SA(0, 1), cA + hstep, voffA);
        if (wr == 1) PG8_BAR;
        PG8_WAIT_V(2); PG8_BAR;
        PG8_STAGE(PG8_SB(1, 0), cB + kstep, voffB); PG8_STAGE(PG8_SA(1, 0), cA + kstep, voffA); PG8_STAGE(PG8_SB(1, 1), cB + hstep + kstep, voffB);
        PG8_WAIT_V(6); PG8_BAR;
    } else {
        PG8_STAGE(PG8_SB(0, 0), cB, voffB); PG8_STAGE(PG8_SA(0, 0), cA, voffA); PG8_STAGE(PG8_SB(0, 1), cB + hstep, voffB); PG8_STAGE(PG8_SA(0, 1), cA + hstep, voffA);
        if (wr == 1) PG8_BAR;
        PG8_WAIT_V(4); PG8_BAR;
        PG8_STAGE(PG8_SB(1, 0), cB + kstep, voffB); PG8_STAGE(PG8_SA(1, 0), cA + kstep, voffA); PG8_STAGE(PG8_SB(1, 1), cB + hstep + kstep, voffB);
        PG8_WAIT_V(6); PG8_BAR;
    }
    for (;;) {
        const bool has_next = S.next(ui + 1, nxt);
        const char* nA = has_next ? (const char*)g.A + (size_t)nxt.pm * tstep : cA; const char* nB = has_next ? (const char*)g.Bt + (size_t)nxt.pn * tstep : cB;
        for (int t = 0; t < nt; t += 2) {
            const bool last = (t == nt - 2);
            const char* a1 = cA + (size_t)(t + 1) * kstep;
            const char* a2 = last ? nA : cA + (size_t)(t + 2) * kstep; const char* b2 = last ? nB : cB + (size_t)(t + 2) * kstep;
            const char* a3 = a2 + kstep; const char* b3 = b2 + kstep;
            if (last && has_next) S.a_ready(nxt);
            if constexpr (SP2) {
            PG8_LDB(B0, 0, 0); PG8_LDB(B1, 0, 1); PG8_SCHED; PG8_LDA(At, 0, 0); PG8_STAGE(PG8_SA(1, 1), a1 + hstep, voffA);
            PG8_WAIT_V(8); PG8_WAIT_L(0); PG8_BAR; PG8_MMA(0, 0, At, B0); PG8_MMA(0, 1, At, B1); PG8_BAR; PG8_SCHED;
            PG8_LDA(At, 0, 1); PG8_STAGE(PG8_SB(0, 0), b2, voffB); PG8_STAGE(PG8_SB(0, 1), b2 + hstep, voffB); PG8_STAGE(PG8_SA(0, 0), a2, voffA);
            PG8_WAIT_V(8); PG8_WAIT_L(0); PG8_BAR; PG8_MMA(1, 0, At, B0); PG8_MMA(1, 1, At, B1); PG8_BAR; PG8_SCHED;
            PG8_LDB(B0, 1, 0); PG8_LDB(B1, 1, 1); PG8_SCHED; PG8_LDA(At, 1, 0); PG8_STAGE(PG8_SA(0, 1), a2 + hstep, voffA);
            PG8_WAIT_V(8); PG8_WAIT_L(0); PG8_BAR; PG8_MMA(0, 0, At, B0); PG8_MMA(0, 1, At, B1); PG8_BAR; PG8_SCHED;
            PG8_LDA(At, 1, 1); PG8_STAGE(PG8_SB(1, 0), b3, voffB); PG8_STAGE(PG8_SB(1, 1), b3 + hstep, voffB); PG8_STAGE(PG8_SA(1, 0), a3, voffA);
            PG8_WAIT_V(8); PG8_WAIT_L(0); PG8_BAR; PG8_MMA(1, 0, At, B0); PG8_MMA(1, 1, At, B1); PG8_BAR; PG8_SCHED;
            } else {
            PG8_LDB(B0, 0, 0); PG8_SCHED; PG8_LDA(At, 0, 0); PG8_STAGE(PG8_SA(1, 1), a1 + hstep, voffA);
            PG8_WAIT_L(8); PG8_BAR; PG8_WAIT_L(0); PG8_MMA(0, 0, At, B0); PG8_BAR; PG8_SCHED;
            PG8_LDB(B1, 0, 1); PG8_STAGE(PG8_SB(0, 0), b2, voffB);
            PG8_BAR; PG8_WAIT_L(0); PG8_MMA(0, 1, At, B1); PG8_BAR;
            PG8_LDA(At, 0, 1); PG8_STAGE(PG8_SA(0, 0), a2, voffA);
            PG8_BAR; PG8_WAIT_L(0); PG8_MMA(1, 0, At, B0); PG8_BAR; PG8_SCHED;
            PG8_STAGE(PG8_SB(0, 1), b2 + hstep, voffB);
            PG8_WAIT_V(6); PG8_BAR; PG8_MMA(1, 1, At, B1); PG8_BAR;
            PG8_LDB(B0, 1, 0); PG8_SCHED; PG8_LDA(At, 1, 0); PG8_STAGE(PG8_SA(0, 1), a2 + hstep, voffA);
            PG8_WAIT_L(8); PG8_BAR; PG8_WAIT_L(0); PG8_MMA(0, 0, At, B0); PG8_BAR; PG8_SCHED;
            PG8_LDB(B1, 1, 1); PG8_STAGE(PG8_SB(1, 0), b3, voffB);
            PG8_BAR; PG8_WAIT_L(0); PG8_MMA(0, 1, At, B1); PG8_BAR;
            PG8_LDA(At, 1, 1); PG8_STAGE(PG8_SA(1, 0), a3, voffA);
            PG8_BAR; PG8_WAIT_L(0); PG8_MMA(1, 0, At, B0); PG8_BAR; PG8_SCHED;
            PG8_STAGE(PG8_SB(1, 1), b3 + hstep, voffB);
            PG8_WAIT_V(6); PG8_BAR; PG8_MMA(1, 1, At, B1); PG8_BAR;
            }
        }
        if constexpr (ALIGN_EPI) { if (wr == 0) PG8_BAR; }
        if constexpr (!Epi::AFTER_DRAIN) { E(acc, cur, wr, wc, fr, fq); S.done(cur); }
        if (!has_next) break;
#pragma unroll
        for (int a = 0; a < 2; ++a)
#pragma unroll
            for (int b = 0; b < 2; ++b)
#pragma unroll
                for (int m = 0; m < 4; ++m)
#pragma unroll
                    for (int n = 0; n < 2; ++n) acc[a][b][m][n] = (f32x4){0.f, 0.f, 0.f, 0.f};
        cur = nxt; cA = nA; cB = nB; ++ui;
        if constexpr (ALIGN_EPI) { if (wr == 1) PG8_BAR; }
    }
    PG8_WAIT_V(0);
    if constexpr (!ALIGN_EPI) { if (wr == 0) PG8_BAR; }
    PG8_BAR;
    if constexpr (Epi::AFTER_DRAIN) { E.fused(acc, cur, wr, wc, fr, fq, lds, wid, lane); S.done(cur); }
#undef PG8_SA
#undef PG8_SB
#undef PG8_STAGE
#undef PG8_LDA
#undef PG8_LDB
#undef PG8_MMA
#undef PG8_WAIT_V
#undef PG8_WAIT_L
#undef PG8_BAR
#undef PG8_SCHED
}
}
#define LAS __attribute__((address_space(3)))
typedef unsigned short bf16;
typedef short bf16x8 __attribute__((ext_vector_type(8)));
typedef short s16x4 __attribute__((ext_vector_type(4)));
typedef short v4i16_t __attribute__((ext_vector_type(4)));
typedef float f32x4 __attribute__((ext_vector_type(4)));
typedef float f32x16 __attribute__((ext_vector_type(16)));
typedef unsigned u32x4 __attribute__((ext_vector_type(4)));
typedef unsigned u32x2 __attribute__((ext_vector_type(2)));

constexpr int NWAVES = 8, NTHR = 512;
constexpr int BATCH = 2, SEQ = 8192, DM = 1024, FF = 2816, M = BATCH * SEQ, NMOD = 9 * DM;
constexpr float EPS = 1e-6f;
constexpr size_t MiB = 1u << 20;
constexpr size_t WS_MOD = 1 * MiB;
constexpr size_t WS_WGU = 2 * MiB;
constexpr size_t WS_WD = WS_WGU + 8 * 11 * MiB;
constexpr size_t WS_WINAB = WS_WD + 44 * MiB;
constexpr size_t WS_WOUTAB = WS_WINAB + 8 * MiB;
constexpr size_t WS_WINC = WS_WOUTAB + 4 * MiB;
constexpr size_t WS_WOUTC = WS_WINC + 12 * MiB;
constexpr size_t WS_H = WS_WOUTC + 4 * MiB;
constexpr size_t WS_MIX = WS_H + 32 * MiB;
constexpr size_t WS_ACT = WS_MIX + 32 * MiB;
constexpr size_t WS_END = WS_ACT + 96 * MiB;
constexpr int LDS_BYTES = 147456;

__device__ __forceinline__ unsigned pk2(float lo, float hi) { return pg8::cvt_pk_bf16(lo, hi); }
__device__ __forceinline__ float bflo(unsigned w) { return __uint_as_float(w << 16); }
__device__ __forceinline__ float bfhi(unsigned w) { return __uint_as_float(w & 0xffff0000u); }
__device__ __forceinline__ float wave_sum(float v) {
#pragma unroll
    for (int o = 1; o < 64; o <<= 1) v += __shfl_xor(v, o);
    return v;
}
struct Args { const float* in[21]; float* out; unsigned char* ws; int ph_lo, ph_hi; };

__device__ __forceinline__ void tr_flush(bf16* WT, int ldk, int k0, int drow0, LAS float* scr, int lane) {
    asm volatile("s_waitcnt lgkmcnt(0)" ::: "memory");
    const int c = lane & 7;
#pragma unroll
    for (int j = 0; j < 4; ++j) { const int n = (lane >> 3) + 8 * j; const LAS float* s = scr + (8 * c) * 33 + n;
        u32x4 o; o.x = pk2(s[0 * 33], s[1 * 33]); o.y = pk2(s[2 * 33], s[3 * 33]); o.z = pk2(s[4 * 33], s[5 * 33]); o.w = pk2(s[6 * 33], s[7 * 33]);
        *(u32x4*)(WT + (size_t)(drow0 + n) * ldk + k0 + 8 * c) = o; }
    asm volatile("s_waitcnt lgkmcnt(0)" ::: "memory");
}
__device__ __forceinline__ void tr_item(const float* W, int ldn, int k0, int n0, bf16* WT, int ldk, int drow0, LAS float* scr, int lane) {
#pragma unroll 8
    for (int i = 0; i < 32; ++i) { const int kk = 2 * i + (lane >> 5); scr[kk * 33 + (lane & 31)] = W[(size_t)(k0 + kk) * ldn + n0 + (lane & 31)]; }
    tr_flush(WT, ldk, k0, drow0, scr, lane);
}
__device__ __forceinline__ int glu_row(int f, int up) { return 256 * (f >> 7) + (f & 127) + (up ? 128 : 0); }

__device__ __forceinline__ void prep_phase(const Args& A, LAS unsigned char* lds, int tid, int lane, int wave) {
    const int G = gridDim.x, gw = blockIdx.x * NWAVES + wave, NGW = G * NWAVES;
    bf16* const WGU = (bf16*)(A.ws + WS_WGU); bf16* const WD = (bf16*)(A.ws + WS_WD); bf16* const WINAB = (bf16*)(A.ws + WS_WINAB);
    bf16* const WOUTAB = (bf16*)(A.ws + WS_WOUTAB); bf16* const WINC = (bf16*)(A.ws + WS_WINC); bf16* const WOUTC = (bf16*)(A.ws + WS_WOUTC);
    {
        LAS float* ca = (LAS float*)(lds);
        LAS float* red = (LAS float*)(lds + 8192);
        for (int i = tid; i < 2 * DM; i += NTHR) { const float v = A.in[1][i]; ca[i] = v / (1.0f + __expf(-v)); }
        __syncthreads();
        float* mod = (float*)(A.ws + WS_MOD);
        for (int task = blockIdx.x; task < 4 * 144; task += G) {
            const int l = task / 144, cgp = task % 144;
            const float* wp = A.in[3] + (size_t)l * DM * NMOD + (size_t)(wave * 128) * NMOD + cgp * 64 + lane;
            float a0 = 0.f, a1 = 0.f;
#pragma unroll 16
            for (int k = 0; k < 128; ++k) { const float w = wp[(size_t)k * NMOD]; a0 += ca[wave * 128 + k] * w; a1 += ca[DM + wave * 128 + k] * w; }
            red[(wave * 2 + 0) * 64 + lane] = a0; red[(wave * 2 + 1) * 64 + lane] = a1;
            __syncthreads();
            if (tid < 128) { const int b = tid >> 6; float s = 0.f;
#pragma unroll
                for (int w = 0; w < 8; ++w) s += red[(w * 2 + b) * 64 + lane];
                mod[(size_t)(l * 2 + b) * NMOD + cgp * 64 + lane] = s + A.in[4][(size_t)l * NMOD + cgp * 64 + lane]; }
            __syncthreads();
        }
    }
    LAS float* scr = (LAS float*)(lds + wave * 16384);
    constexpr int N_FFN = 8 * 4224, N_INAB = 2 * 1024, N_OUTAB = 2 * 256, N_POOL = 2 * 256, N_INC = 2 * 1536, N_OUTC = 2 * 512;
    constexpr int NITEMS = N_FFN + N_INAB + N_OUTAB + N_POOL + N_INC + N_OUTC;
    for (int it = gw; it < NITEMS; it += NGW) {
        int r = it;
        if (r < N_FFN) { const int lj = r / 4224, q = r % 4224, which = q / 1408, q2 = q % 1408;
            if (which < 2) { const int kb = q2 / 88, nb = q2 % 88, f0 = 32 * nb;
                tr_item((which == 0 ? A.in[5] : A.in[6]) + (size_t)lj * DM * FF, FF, 64 * kb, f0, WGU + (size_t)lj * 5632 * 1024, 1024, glu_row(f0, which), scr, lane); }
            else { const int kb = q2 / 32, nb = q2 % 32; tr_item(A.in[7] + (size_t)lj * FF * DM, DM, 64 * kb, 32 * nb, WD + (size_t)lj * 1024 * FF, FF, 32 * nb, scr, lane); }
            continue; }
        r -= N_FFN;
        if (r < N_INAB) { const int e = r / 1024, q = r % 1024, kb = q / 64, nb = q % 64;
            tr_item(A.in[8] + (size_t)e * DM * 2048, 2048, 64 * kb, 32 * nb, WINAB + (size_t)e * 2048 * 1024, 1024, 32 * nb, scr, lane); continue; }
        r -= N_INAB;
        if (r < N_OUTAB) { const int e = r / 256, q = r % 256, kb = q / 32, nb = q % 32;
            tr_item(A.in[17] + (size_t)e * DM * DM, DM, 64 * kb, 32 * nb, WOUTAB + (size_t)e * DM * DM, DM, 32 * nb, scr, lane); continue; }
        r -= N_OUTAB;
        if (r < N_POOL) {
            const int e = r / 256, q = r % 256, kb = q / 32, nb = q % 32, g = kb >> 1, c0 = (kb & 1) * 64, n0 = 32 * nb;
            const float* pw = A.in[15] + ((size_t)(e * 4 + g) * 128 + c0 + lane) * 128;
            const float* ps = A.in[16] + e * 512 + g * 128;
            const float* wo = A.in[17] + (size_t)e * DM * DM + (size_t)(512 + g * 128) * DM + n0;
            float acc[32];
#pragma unroll
            for (int n = 0; n < 32; ++n) acc[n] = 0.f;
            for (int d = 0; d < 128; ++d) { const float pv = pw[d] * ps[d]; const float* wr = wo + (size_t)d * DM;
#pragma unroll
                for (int n = 0; n < 32; ++n) acc[n] += pv * wr[n]; }
#pragma unroll
            for (int n = 0; n < 32; ++n) scr[lane * 33 + n] = acc[n];
            tr_flush(WOUTAB + (size_t)e * DM * DM, DM, 512 + 64 * kb, n0, scr, lane); continue; }
        r -= N_POOL;
        if (r < N_INC) { const int o = r / 1536, q = r % 1536, kb = q / 96, nb = q % 96, c0 = 32 * nb;
            const int drow = c0 < 1024 ? c0 : (c0 < 2048 ? 1024 + glu_row(c0 - 1024, 0) : 1024 + glu_row(c0 - 2048, 1));
            tr_item(A.in[18] + (size_t)o * DM * 3072, 3072, 64 * kb, c0, WINC + (size_t)o * 3072 * 1024, 1024, drow, scr, lane); continue; }
        r -= N_INC;
        { const int o = r / 512, q = r % 512, kb = q / 32, nb = q % 32;
            tr_item(A.in[20] + (size_t)o * DM * DM, DM, 64 * kb, 32 * nb, WOUTC + (size_t)o * DM * DM, DM, 32 * nb, scr, lane); }
    }
}

__device__ __forceinline__ void norm_phase(const float* x, bf16* h, const float* g, const float* shift, const float* scale, int lane, int wave) {
    const int gw = blockIdx.x * NWAVES + wave, NGW = gridDim.x * NWAVES;
    for (int m = gw; m < M; m += NGW) {
        const int b = m / SEQ;
        const f32x4* xr = (const f32x4*)(x + (size_t)m * DM) + lane;
        f32x4 v[4]; float s = 0.f;
#pragma unroll
        for (int j = 0; j < 4; ++j) { v[j] = xr[64 * j]; s += (v[j].x * v[j].x + v[j].y * v[j].y) + (v[j].z * v[j].z + v[j].w * v[j].w); }
        const float rstd = 1.0f / sqrtf(wave_sum(s) * (1.0f / DM) + EPS);
        u32x2* o8 = (u32x2*)(h + (size_t)m * DM) + lane;
#pragma unroll
        for (int j = 0; j < 4; ++j) {
            const f32x4 gv = ((const f32x4*)g)[lane + 64 * j], sc = ((const f32x4*)(scale + (size_t)b * NMOD))[lane + 64 * j], sh = ((const f32x4*)(shift + (size_t)b * NMOD))[lane + 64 * j];
            const f32x4 y = (v[j] * rstd) * gv * (sc + 1.0f) + sh;
            u32x2 w; w.x = pk2(y.x, y.y); w.y = pk2(y.z, y.w); o8[64 * j] = w; }
    }
}

__device__ __forceinline__ void pool_phase(const bf16* proj  , bf16* mix, int lane, int wave) {
    const int gw = blockIdx.x * NWAVES + wave, NGW = gridDim.x * NWAVES;
    const int g = lane >> 4, w = 2 << g;
    for (int m = gw; m < M; m += NGW) {
        const int t = m % SEQ;
        const bf16* up = proj + (size_t)m * 2048 + 1536 + 8 * lane;
        const u32x4 c = *(const u32x4*)up;
        float s[8] = {bflo(c.x), bfhi(c.x), bflo(c.y), bfhi(c.y), bflo(c.z), bfhi(c.z), bflo(c.w), bfhi(c.w)};
        float cur[8];
#pragma unroll
        for (int e = 0; e < 8; ++e) cur[e] = s[e];
        const int cnt = (t + 1 < w) ? t + 1 : w;
        for (int j = 1; j < 16; ++j) { if (j < cnt) { const u32x4 p = *(const u32x4*)(up - (size_t)j * 2048);
            s[0] += bflo(p.x); s[1] += bfhi(p.x); s[2] += bflo(p.y); s[3] += bfhi(p.y); s[4] += bflo(p.z); s[5] += bfhi(p.z); s[6] += bflo(p.w); s[7] += bfhi(p.w); } }
        const float inv = 1.0f / (float)cnt;
        u32x4 o; o.x = pk2(s[0] * inv - cur[0], s[1] * inv - cur[1]); o.y = pk2(s[2] * inv - cur[2], s[3] * inv - cur[3]);
        o.z = pk2(s[4] * inv - cur[4], s[5] * inv - cur[5]); o.w = pk2(s[6] * inv - cur[6], s[7] * inv - cur[7]);
        *(u32x4*)(mix + (size_t)m * DM + 512 + 8 * lane) = o;
    }
}

__device__ __forceinline__ void conv_phase(const bf16* proj  , bf16* mix, const float* cw  , int tid) {
    const int gt = blockIdx.x * NTHR + tid, NGT = gridDim.x * NTHR;
    for (int i = gt; i < M * 128; i += NGT) {
        const int m = i >> 7, c8 = (i & 127) * 8, t = m % SEQ;
        const bf16* bp = proj + (size_t)m * 2048 + c8; const bf16* vp = bp + 1024;
        const u32x4 bb = *(const u32x4*)bp, v0 = *(const u32x4*)vp;
        u32x4 v1 = (u32x4){0u, 0u, 0u, 0u}, v2 = (u32x4){0u, 0u, 0u, 0u};
        if (t >= 1) v1 = *(const u32x4*)(vp - 2048);
        if (t >= 2) v2 = *(const u32x4*)(vp - 4096);
        const f32x4 w0a = *(const f32x4*)(cw + c8), w0b = *(const f32x4*)(cw + c8 + 4), w1a = *(const f32x4*)(cw + 1024 + c8), w1b = *(const f32x4*)(cw + 1024 + c8 + 4),
                    w2a = *(const f32x4*)(cw + 2048 + c8), w2b = *(const f32x4*)(cw + 2048 + c8 + 4);
        float y[8];
#define CV(e, W0, W1, W2, word, HI) y[e] = (HI ? bfhi(bb.word) : bflo(bb.word)) * (W0 * (HI ? bfhi(v2.word) : bflo(v2.word)) + W1 * (HI ? bfhi(v1.word) : bflo(v1.word)) + W2 * (HI ? bfhi(v0.word) : bflo(v0.word)))
        CV(0, w0a.x, w1a.x, w2a.x, x, 0); CV(1, w0a.y, w1a.y, w2a.y, x, 1); CV(2, w0a.z, w1a.z, w2a.z, y, 0); CV(3, w0a.w, w1a.w, w2a.w, y, 1);
        CV(4, w0b.x, w1b.x, w2b.x, z, 0); CV(5, w0b.y, w1b.y, w2b.y, z, 1); CV(6, w0b.z, w1b.z, w2b.z, w, 0); CV(7, w0b.w, w1b.w, w2b.w, w, 1);
#undef CV
        u32x4 o; o.x = pk2(y[0], y[1]); o.y = pk2(y[2], y[3]); o.z = pk2(y[4], y[5]); o.w = pk2(y[6], y[7]);
        *(u32x4*)(mix + (size_t)m * DM + c8) = o;
    }
}

namespace att {
constexpr int STAGE = 32768, OFF_K = 0, OFF_V = 16384, OFF_WS = 65536;
__device__ __forceinline__ int crow(int i, int h) { return (i & 3) + 8 * (i >> 2) + 4 * h; }
__device__ __forceinline__ s16x4 vtr(const LAS unsigned char* p) { return __builtin_bit_cast(s16x4, __builtin_amdgcn_ds_read_tr16_b64_v4i16((LAS v4i16_t*)p)); }
#define MFMA32(a, b, c) __builtin_amdgcn_mfma_f32_32x32x16_bf16((a), (b), (c), 0, 0, 0)

struct TileRegs { u32x4 k1, k2, v0, v1; };
__device__ __forceinline__ void tile_load(TileRegs& R, const bf16* proj, size_t rowbase, int hd, int t, int tid) {
    const int kv = tid >> 3, c = tid & 7;
    const bf16* kp = proj + (rowbase + (size_t)(64 * t + kv)) * 2048 + 512 + hd * 128 + 8 * c;
    R.k1 = *(const u32x4*)kp; R.k2 = *(const u32x4*)(kp + 64);
    const int kvv = tid >> 4, ch = tid & 15;
    const bf16* vp = proj + (rowbase + (size_t)(64 * t + kvv)) * 2048 + 1024 + hd * 128 + 8 * ch;
    R.v0 = *(const u32x4*)vp; R.v1 = *(const u32x4*)(vp + (size_t)32 * 2048);
}
__device__ __forceinline__ u32x4 knorm(u32x4 k, const f32x4 ga, const f32x4 gb) {
    const float g[8] = {ga.x, ga.y, ga.z, ga.w, gb.x, gb.y, gb.z, gb.w};
    float f[8] = {bflo(k.x), bfhi(k.x), bflo(k.y), bfhi(k.y), bflo(k.z), bfhi(k.z), bflo(k.w), bfhi(k.w)};
    float ss = 0.f;
#pragma unroll
    for (int e = 0; e < 8; ++e) ss += f[e] * f[e];
    ss += __shfl_xor(ss, 1); ss += __shfl_xor(ss, 2); ss += __shfl_xor(ss, 4);
    const float rstd = 1.0f / sqrtf(ss * (1.0f / 64.0f) + EPS);
    u32x4 o; o.x = pk2(f[0] * rstd * g[0], f[1] * rstd * g[1]); o.y = pk2(f[2] * rstd * g[2], f[3] * rstd * g[3]);
    o.z = pk2(f[4] * rstd * g[4], f[5] * rstd * g[5]); o.w = pk2(f[6] * rstd * g[6], f[7] * rstd * g[7]); return o;
}
__device__ __forceinline__ void tile_store(const TileRegs& R, LAS unsigned char* st, const float* gk8, int tid) {
    const int kv = tid >> 3, c = tid & 7;
    const f32x4 ga = *(const f32x4*)gk8, gb = *(const f32x4*)(gk8 + 4);
    *(LAS u32x4*)(st + OFF_K + c * 1024 + kv * 16) = knorm(R.k1, ga, gb);
    *(LAS u32x4*)(st + OFF_K + 8192 + c * 1024 + kv * 16) = knorm(R.k2, ga, gb);
    const int kvv = tid >> 4, ch = tid & 15;
    const int a0 = ((ch >> 2) * 4 + (kvv >> 4)) * 1024 + (kvv & 15) * 64 + (ch & 3) * 16;
    *(LAS u32x4*)(st + OFF_V + a0) = R.v0;
    *(LAS u32x4*)(st + OFF_V + a0 + 2048) = R.v1;
}

__device__ __forceinline__ void attn_unit(LAS unsigned char* lds, const bf16* proj, bf16* mix, int b, int hd, int qb, const float* qkg  , const float* subg  , float lam, float oscale, int tid) {
    const int lane = tid & 63, r = lane & 31, h = lane >> 5; const int wid = __builtin_amdgcn_readfirstlane(tid >> 6);
    const int sub = wid >> 2, wq = wid & 3;
    const size_t rowbase = (size_t)b * SEQ; const int q0 = qb * 128, qw = q0 + wq * 32;
    const int NT = 2 * qb + 2, ntw = (qw >> 6) + 1;
    LAS float* wsf = (LAS float*)(lds + OFF_WS) + wid * 64;
    const float* gk8 = qkg + 64 + 8 * (tid & 7);
    TileRegs R; tile_load(R, proj, rowbase, hd, 0, tid);
    bf16x8 qr[4];
    {
        const bf16* qp = proj + (rowbase + (size_t)(qw + r)) * 2048 + hd * 128 + sub * 64 + 8 * h;
        u32x4 raw[4]; float ss = 0.f;
#pragma unroll
        for (int d0 = 0; d0 < 4; ++d0) { raw[d0] = *(const u32x4*)(qp + 16 * d0);
            const float f0 = bflo(raw[d0].x), f1 = bfhi(raw[d0].x), f2 = bflo(raw[d0].y), f3 = bfhi(raw[d0].y), f4 = bflo(raw[d0].z), f5 = bfhi(raw[d0].z), f6 = bflo(raw[d0].w), f7 = bfhi(raw[d0].w);
            ss += (f0 * f0 + f1 * f1) + (f2 * f2 + f3 * f3) + (f4 * f4 + f5 * f5) + (f6 * f6 + f7 * f7); }
        ss += __shfl_xor(ss, 32);
        const float sc = (1.0f / sqrtf(ss * (1.0f / 64.0f) + EPS)) * (0.125f * 1.4426950408889634f);
#pragma unroll
        for (int d0 = 0; d0 < 4; ++d0) { const float* gq = qkg + 16 * d0 + 8 * h;
            u32x4 o; o.x = pk2(bflo(raw[d0].x) * sc * gq[0], bfhi(raw[d0].x) * sc * gq[1]); o.y = pk2(bflo(raw[d0].y) * sc * gq[2], bfhi(raw[d0].y) * sc * gq[3]);
            o.z = pk2(bflo(raw[d0].z) * sc * gq[4], bfhi(raw[d0].z) * sc * gq[5]); o.w = pk2(bflo(raw[d0].w) * sc * gq[6], bfhi(raw[d0].w) * sc * gq[7]);
            qr[d0] = __builtin_bit_cast(bf16x8, o); }
    }
    tile_store(R, lds, gk8, tid);
    __syncthreads();
    f32x16 o[4];
#pragma unroll
    for (int d = 0; d < 4; ++d)
#pragma unroll
        for (int i = 0; i < 16; ++i) o[d][i] = 0.f;
    float mref = -INFINITY, lsum = 0.f;
    const int vlane = (4 * h + ((lane & 15) >> 2)) * 64 + ((lane >> 4) & 1) * 32 + (lane & 3) * 8;
    for (int t = 0; t < NT; ++t) {
        const bool more = (t + 1 < NT);
        if (more) tile_load(R, proj, rowbase, hd, t + 1, tid);
        if (t < ntw) {
            const LAS unsigned char* st = lds + (t & 1) * STAGE;
            const LAS unsigned char* kb = st + OFF_K + sub * 8192 + h * 1024 + r * 16;
            f32x16 p0, p1;
#pragma unroll
            for (int i = 0; i < 16; ++i) { p0[i] = 0.f; p1[i] = 0.f; }
#pragma unroll
            for (int d0 = 0; d0 < 4; ++d0) { const bf16x8 a0 = *(const LAS bf16x8*)(kb + d0 * 2048), a1 = *(const LAS bf16x8*)(kb + d0 * 2048 + 512);
                p0 = MFMA32(a0, qr[d0], p0); p1 = MFMA32(a1, qr[d0], p1); }
            if (t == ntw - 1) { const int thr = qw + r - 64 * t;
#pragma unroll
                for (int i = 0; i < 16; ++i) { const int kl = crow(i, h); if (kl > thr) p0[i] = -INFINITY; if (kl + 32 > thr) p1[i] = -INFINITY; } }
            float mx = fmaxf(p0[0], p1[0]);
#pragma unroll
            for (int i = 1; i < 16; ++i) mx = fmaxf(mx, fmaxf(p0[i], p1[i]));
            mx = fmaxf(mx, __shfl_xor(mx, 32));
            if (__any(mx > mref + 8.0f)) {
                const float mnew = fmaxf(mref, mx), alpha = __builtin_amdgcn_exp2f(mref - mnew);
                mref = mnew; lsum *= alpha;
                if (h == 0) wsf[r] = alpha;
                asm volatile("s_waitcnt lgkmcnt(0)" ::: "memory");
#pragma unroll
                for (int i = 0; i < 16; ++i) { const float a = wsf[crow(i, h)];
#pragma unroll
                    for (int d = 0; d < 4; ++d) o[d][i] *= a; }
            }
            float ps = 0.f;
#pragma unroll
            for (int i = 0; i < 16; ++i) { p0[i] = __builtin_amdgcn_exp2f(p0[i] - mref); p1[i] = __builtin_amdgcn_exp2f(p1[i] - mref); ps += p0[i] + p1[i]; }
            lsum += ps;
            bf16x8 pa[4];
            { u32x4 w;
              w.x = pk2(p0[0], p0[1]); w.y = pk2(p0[2], p0[3]); w.z = pk2(p0[4], p0[5]); w.w = pk2(p0[6], p0[7]); pa[0] = __builtin_bit_cast(bf16x8, w);
              w.x = pk2(p0[8], p0[9]); w.y = pk2(p0[10], p0[11]); w.z = pk2(p0[12], p0[13]); w.w = pk2(p0[14], p0[15]); pa[1] = __builtin_bit_cast(bf16x8, w);
              w.x = pk2(p1[0], p1[1]); w.y = pk2(p1[2], p1[3]); w.z = pk2(p1[4], p1[5]); w.w = pk2(p1[6], p1[7]); pa[2] = __builtin_bit_cast(bf16x8, w);
              w.x = pk2(p1[8], p1[9]); w.y = pk2(p1[10], p1[11]); w.z = pk2(p1[12], p1[13]); w.w = pk2(p1[14], p1[15]); pa[3] = __builtin_bit_cast(bf16x8, w); }
            const LAS unsigned char* vb = st + OFF_V + vlane;
#pragma unroll
            for (int db = 0; db < 4; ++db) { __builtin_amdgcn_sched_barrier(0);
#pragma unroll
                for (int s = 0; s < 4; ++s) { const s16x4 lo = vtr(vb + (db * 4 + s) * 1024), hi = vtr(vb + (db * 4 + s) * 1024 + 512);
                    const bf16x8 vf = __builtin_shufflevector(lo, hi, 0, 1, 2, 3, 4, 5, 6, 7);
                    o[db] = MFMA32(pa[s], vf, o[db]); } }
        }
        if (more) tile_store(R, lds + ((t + 1) & 1) * STAGE, gk8, tid);
        __syncthreads();
    }
    lsum += __shfl_xor(lsum, 32);
    const float inv = (sub ? lam : 1.0f) / lsum;
    if (h == 0) wsf[r] = inv;
    asm volatile("s_waitcnt lgkmcnt(0)" ::: "memory");
#pragma unroll
    for (int i = 0; i < 16; ++i) { const float a = wsf[crow(i, h)];
#pragma unroll
        for (int d = 0; d < 4; ++d) o[d][i] *= a; }
    LAS float* xo = (LAS float*)(lds + wq * 16384);
    if (sub == 1) {
#pragma unroll
        for (int d = 0; d < 4; ++d)
#pragma unroll
            for (int i = 0; i < 16; ++i) xo[crow(i, h) * 128 + 32 * d + r] = o[d][i];
    }
    __syncthreads();
    if (sub == 0) {
#pragma unroll
        for (int d = 0; d < 4; ++d)
#pragma unroll
            for (int i = 0; i < 16; ++i) { const int a = crow(i, h) * 128 + 32 * d + r; xo[a] = o[d][i] - xo[a]; }
    }
    __syncthreads();
    if (sub == 0) {
        const int row = lane >> 1, half = lane & 1;
        const LAS f32x4* src = (const LAS f32x4*)(xo + row * 128 + half * 64);
        f32x4 v[16]; float ss = 0.f;
#pragma unroll
        for (int j = 0; j < 16; ++j) { v[j] = src[j]; ss += (v[j].x * v[j].x + v[j].y * v[j].y) + (v[j].z * v[j].z + v[j].w * v[j].w); }
        ss += __shfl_xor(ss, 1);
        const float rstd = (1.0f / sqrtf(ss * (1.0f / 128.0f) + EPS)) * oscale;
        bf16* dst = mix + (rowbase + (size_t)(qw + row)) * DM + hd * 128 + half * 64;
        const f32x4* gs = (const f32x4*)(subg + half * 64);
#pragma unroll
        for (int j = 0; j < 8; ++j) { const f32x4 a = v[2 * j] * rstd * gs[2 * j], c = v[2 * j + 1] * rstd * gs[2 * j + 1];
            u32x4 w; w.x = pk2(a.x, a.y); w.y = pk2(a.z, a.w); w.z = pk2(c.x, c.y); w.w = pk2(c.z, c.w); *(u32x4*)(dst + 8 * j) = w; }
    }
    __syncthreads();
}
}

__global__ void __launch_bounds__(NTHR, 2) fwd_kernel(Args A) {
    extern __shared__ __attribute__((aligned(16))) unsigned char lds_raw[];
    LAS unsigned char* lds = (LAS unsigned char*)lds_raw;
    cg::grid_group grid = cg::this_grid();
    for (int ph = A.ph_lo; ph < A.ph_hi; ++ph) {
        int tid_o = threadIdx.x; asm volatile("" : "+v"(tid_o));
        const int tid = tid_o, lane = tid & 63, wave = __builtin_amdgcn_readfirstlane(tid >> 6);
        const int G = gridDim.x;
        unsigned char* ws = A.ws; asm volatile("" : "+s"(ws));
        float* const mod = (float*)(ws + WS_MOD);
        bf16* const Hb = (bf16*)(ws + WS_H); bf16* const MIXb = (bf16*)(ws + WS_MIX); bf16* const ACTb = (bf16*)(ws + WS_ACT);
        if (ph == 0) { prep_phase(A, lds, tid, lane, wave); }
        else {
            const int l = (ph - 1) / 10, s = (ph - 1) % 10, e = l >> 1;
            const float* modl = mod + (size_t)l * 2 * NMOD;
            const float* xcur = (ph <= 3) ? A.in[0] : A.out;
            if (s == 0 || s == 3 || s == 7) {
                const int j = (s == 0) ? 0 : (s == 3 ? 1 : 2);
                norm_phase(xcur, Hb, A.in[2] + (size_t)(l * 3 + j) * DM, modl + (3 * j) * DM, modl + (3 * j + 1) * DM, lane, wave);
            } else if (s == 1 || s == 8 || s == 4) {
                const bf16* W; int N, ldc, pn0, colbase, act;
                if (s != 4) { W = (const bf16*)(ws + WS_WGU) + (size_t)(l * 2 + (s == 1 ? 0 : 1)) * 5632 * 1024; N = 5632; ldc = FF; pn0 = 0; colbase = 0; act = 1; }
                else if ((l & 1) == 0) { W = (const bf16*)(ws + WS_WINAB) + (size_t)e * 2048 * 1024; N = 2048; ldc = 2048; pn0 = 8; colbase = 0; act = 0; }
                else { W = (const bf16*)(ws + WS_WINC) + (size_t)e * 3072 * 1024; N = 3072; ldc = 2048; pn0 = 4; colbase = 1024; act = 0; }
                pg8::Gemm g{Hb, W, M, N, DM}; pg8::StaticOrder S; S.init(M, N, G, (int)blockIdx.x);
                pg8::EpiMix E{ACTb, ldc, pn0, colbase, act};
                pg8::gemm_phase<pg8::EpiMix, pg8::StaticOrder, true, true>(lds, g, S, E);
            } else if (s == 2 || s == 9 || s == 6) {
                const bf16* Ain; const bf16* W; int K; const float* gate; float gs;
                if (s != 6) { Ain = ACTb; W = (const bf16*)(ws + WS_WD) + (size_t)(l * 2 + (s == 2 ? 0 : 1)) * 1024 * FF; K = FF; gate = modl + (s == 2 ? 2 : 8) * DM; gs = 0.5f; }
                else { Ain = MIXb; W = ((l & 1) == 0 ? (const bf16*)(ws + WS_WOUTAB) : (const bf16*)(ws + WS_WOUTC)) + (size_t)e * DM * DM; K = DM; gate = modl + 5 * DM; gs = 1.0f; }
                pg8::Gemm g{Ain, W, M, DM, K}; pg8::StaticOrder S; S.init(M, DM, G, (int)blockIdx.x);
                pg8::EpiRes E{xcur, A.out, gate, gs};
                pg8::gemm_phase<pg8::EpiRes, pg8::StaticOrder, true, true>(lds, g, S, E);
            } else {
                if ((l & 1) == 0) {
                    pool_phase(ACTb, MIXb, lane, wave);
                    const float* lq1 = A.in[10] + e * 64; const float* lk1 = A.in[11] + e * 64; const float* lq2 = A.in[12] + e * 64; const float* lk2 = A.in[13] + e * 64;
                    float s1 = 0.f, s2 = 0.f;
                    for (int i = 0; i < 64; ++i) { s1 += lq1[i] * lk1[i]; s2 += lq2[i] * lk2[i]; }
                    const float lam_init = 0.8f - 0.6f * expf(-0.3f * (float)l);
                    const float lam = expf(s1) - expf(s2) + lam_init;
                    for (int ui = 0; ui < 2; ++ui) {
                        for (int v = blockIdx.x; v < 256; v += G) {
                            const int bh = v >> 5, x = v & 31, qb = ui == 0 ? 63 - x : x;
                            att::attn_unit(lds, ACTb, MIXb, bh >> 2, bh & 3, qb, A.in[9] + e * 128, A.in[14] + e * 128, lam, 1.0f - lam_init, tid);
                        }
                    }
                } else conv_phase(ACTb, MIXb, A.in[19] + (size_t)e * 3 * DM, tid);
            }
        }
        if (ph + 1 < A.ph_hi) grid.sync();
    }
}

#ifndef N_LAUNCH_MODE
#define N_LAUNCH_MODE 0
#endif
extern "C" void kernel_launch(void* const* d_in, const int* in_sizes, int n_in, void* d_out, int out_size, void* d_ws, size_t ws_size, hipStream_t stream) {
    static int grid = 0;
    if (grid == 0) {
        if (n_in != 21 || out_size != M * DM || ws_size < WS_END) { fprintf(stderr, "kernel_launch: unexpected problem (n_in %d out %d ws %zu)\n", n_in, out_size, ws_size); grid = -1; return; }
        int dev = 0, cus = 0, per_cu = 0;
        hipGetDevice(&dev); hipDeviceGetAttribute(&cus, hipDeviceAttributeMultiprocessorCount, dev);
        if (hipFuncSetAttribute((const void*)fwd_kernel, hipFuncAttributeMaxDynamicSharedMemorySize, LDS_BYTES) != hipSuccess) { fprintf(stderr, "kernel_launch: hipFuncSetAttribute failed\n"); grid = -1; return; }
        if (hipOccupancyMaxActiveBlocksPerMultiprocessor(&per_cu, (const void*)fwd_kernel, NTHR, LDS_BYTES) != hipSuccess || per_cu < 1) { fprintf(stderr, "kernel_launch: occupancy query says %d\n", per_cu); per_cu = 1; }
        (void)hipGetLastError();
        grid = cus * 1;
    }
    if (grid < 0) return;
    Args a{};
    for (int i = 0; i < 21; ++i) a.in[i] = (const float*)d_in[i];
    a.out = (float*)d_out; a.ws = (unsigned char*)d_ws;
    constexpr int NPH = 41;
#if N_LAUNCH_MODE == 0
    for (int ph = 0; ph < NPH; ++ph) { a.ph_lo = ph; a.ph_hi = ph + 1; hipLaunchKernelGGL(fwd_kernel, dim3(grid), dim3(NTHR), LDS_BYTES, stream, a); }
#else
    a.ph_lo = 0; a.ph_hi = NPH;
    void* args[] = {&a};
    hipError_t e = hipLaunchCooperativeKernel((const void*)fwd_kernel, dim3(grid), dim3(NTHR), args, LDS_BYTES, stream);
    if (e != hipSuccess) fprintf(stderr, "cooperative launch failed: %s (grid %d)\n", hipGetErrorString(e), grid);
#endif
}
```

```cpp
#include <hip/hip_runtime.h>
#include <hip/hip_cooperative_groups.h>
#include <cstdio>
#include <cstdint>
namespace cg = cooperative_groups;
namespace pg8 {
#define PG8_LAS __attribute__((address_space(3)))
typedef unsigned short bf16_t;
typedef short bf16x8 __attribute__((ext_vector_type(8)));
typedef float f32x4 __attribute__((ext_vector_type(4)));
typedef unsigned u32x4 __attribute__((ext_vector_type(4)));
constexpr int BM = 256, BK = 64, HALF = 128, HTB = HALF * BK * 2  , STAGE_BYTES = 8 * HTB, NXCD = 8, WGM = 8;

__host__ __device__ __forceinline__ int lds_byte(int r, int c) { const int st = (r >> 4) * 2 + (c >> 5), rr = r & 15, cc = c & 31, ob = rr * 64 + cc * 2; return st * 1024 + (ob ^ (((ob >> 9) & 1) << 5)); }
__host__ __device__ __forceinline__ void stage_rc(int b, int& R, int& C) { const int st = b / 1024, sb = b % 1024, swz = sb ^ (((sb >> 9) & 1) << 5); R = (st >> 1) * 16 + swz / 64; C = (st & 1) * 32 + (swz % 64) / 2; }
__host__ __device__ __forceinline__ int perm32(int rho) { const int n = rho >> 4, i = rho & 15; return 8 * (i >> 2) + 4 * n + (i & 3); }

struct Unit { int pm, pn, half, narrow; };
struct Gemm { const bf16_t* A; const bf16_t* Bt; int M, N, K; int blin; };

struct StaticOrder {
    int nM, nN, nwg, G, c, nfull, tail;
    __host__ __device__ void init(int M, int N, int G_, int c_) { nM = M / BM; nN = N / BM; nwg = nM * nN; G = G_; c = c_; nfull = nwg / G; tail = ((nwg % G) * 2 == G && (G % 16) == 0) ? 1 : 0; }
    __host__ __device__ bool next(int i, Unit& u) const {
        long L = (long)i * G + c; u.half = 0; u.narrow = 0;
        if (tail && i >= nfull) { if (i > nfull) return false; const int x = c % NXCD, li = c / NXCD; L = (long)nfull * G + (li >> 1) * NXCD + x; u.half = li & 1; u.narrow = 1; }
        if (L >= nwg) return false;
        int wgid = (int)L; { const int q = nwg / NXCD, r = nwg % NXCD, xcd = wgid % NXCD, off = wgid / NXCD; wgid = (xcd < r ? xcd * (q + 1) : r * (q + 1) + (xcd - r) * q) + off; }
        const int nig = WGM * nN, gid = wgid / nig, fm = gid * WGM, gsz = (nM - fm) < WGM ? (nM - fm) : WGM;
        u.pm = fm + ((wgid % nig) % gsz); u.pn = (wgid % nig) / gsz; return true;
    }
    __device__ __forceinline__ void a_ready(const Unit&) const {}
    __device__ __forceinline__ void done(const Unit&) const {}
};

typedef float f32x2 __attribute__((ext_vector_type(2)));
typedef __bf16 bf16x2_t __attribute__((ext_vector_type(2)));
__device__ __forceinline__ unsigned cvt_pk_bf16(float lo, float hi) { f32x2 v = {lo, hi}; bf16x2_t b = __builtin_convertvector(v, bf16x2_t); return __builtin_bit_cast(unsigned, b); }
__device__ __forceinline__ float silu_f(float v) { return v * __builtin_amdgcn_rcpf(1.0f + __builtin_amdgcn_exp2f(-1.4426950408889634f * v)); }

#define PG8_GAS __attribute__((address_space(1)))
template <class T> __device__ __forceinline__ T* lds_ptr(const PG8_LAS unsigned* q) { const unsigned lo = __builtin_amdgcn_readfirstlane(q[0]), hi = __builtin_amdgcn_readfirstlane(q[1]); return (T*)(((unsigned long long)hi << 32) | lo); }
__device__ __forceinline__ int lds_int(const PG8_LAS unsigned* q) { return (int)__builtin_amdgcn_readfirstlane(q[0]); }
__device__ __forceinline__ void lds_put(PG8_LAS unsigned* q, const void* p) { const unsigned long long v = (unsigned long long)p; q[0] = (unsigned)v; q[1] = (unsigned)(v >> 32); }
struct EpiMix {
    static constexpr bool PERM = true, AFTER_DRAIN = false;
    const PG8_LAS unsigned* P;
    static __device__ __forceinline__ void put(PG8_LAS unsigned* P, bf16_t* O, int ldc, int pn0, int colbase, int act, const float* rowss, const float* bias, int N, int qkn, const float* qkg) {
        lds_put(P, O); lds_put(P + 2, rowss); lds_put(P + 4, bias); P[6] = ldc; P[7] = pn0; P[8] = colbase; P[9] = act; P[10] = N; P[11] = qkn; lds_put(P + 12, qkg); }
    __device__ __forceinline__ void operator()(const f32x4 (&acc)[2][2][4][2], const Unit& u, int wr, int wc, int fr, int fq) const {
        PG8_GAS bf16_t* const O = (PG8_GAS bf16_t*)lds_ptr<bf16_t>(P); const PG8_GAS float* const rowss = (const PG8_GAS float*)lds_ptr<const float>(P + 2); const PG8_GAS float* const bias = (const PG8_GAS float*)lds_ptr<const float>(P + 4);
        const int ldc = lds_int(P + 6), pn0 = lds_int(P + 7), colbase = lds_int(P + 8), act_silu = lds_int(P + 9), N = lds_int(P + 10);
        const int row0 = u.pm * BM + u.half * HALF + wr * 64 + fr; const int nai = u.narrow ? 1 : 2;
        float rs[2][4];
#pragma unroll
        for (int ai = 0; ai < 2; ++ai)
#pragma unroll
            for (int m = 0; m < 4; ++m) { const PG8_GAS f32x4* sp = (const PG8_GAS f32x4*)(rowss + (size_t)(row0 + (ai < nai ? ai : 0) * HALF + m * 16) * 16);
                const f32x4 a = sp[0], b = sp[1], c = sp[2], d = sp[3];
                const float ss = ((a[0] + a[1]) + (a[2] + a[3])) + ((b[0] + b[1]) + (b[2] + b[3])) + ((c[0] + c[1]) + (c[2] + c[3])) + ((d[0] + d[1]) + (d[2] + d[3]));
                rs[ai][m] = 1.0f / sqrtf(ss * (1.0f / 1024.0f) + 1e-6f); }
        const PG8_GAS float* bp = bias + (size_t)((u.pm * BM) / 8192) * N + u.pn * BM + wc * 32 + 8 * fq;
        f32x4 bv[2][2];
#pragma unroll
        for (int bj = 0; bj < 2; ++bj)
#pragma unroll
            for (int n = 0; n < 2; ++n) bv[bj][n] = *(const PG8_GAS f32x4*)(bp + bj * HALF + 4 * n);
        if (u.pn < pn0 && lds_int(P + 11) != 0 && u.pn < 4) {
            const PG8_GAS float* const qkg = (const PG8_GAS float*)lds_ptr<const float>(P + 12);
            PG8_LAS float* X = (PG8_LAS float*)((PG8_LAS unsigned char*)P - 256 + 4096);
            const int col0 = u.pn * BM + wc * 32 + 8 * fq;
#pragma unroll
            for (int ai = 0; ai < 2; ++ai)
#pragma unroll
                for (int m = 0; m < 4; ++m)
#pragma unroll
                    for (int bj = 0; bj < 2; ++bj) { const f32x4 v0 = acc[ai][bj][m][0] * rs[ai][m] + bv[bj][0], v1 = acc[ai][bj][m][1] * rs[ai][m] + bv[bj][1];
                        float ss = ((v0[0] * v0[0] + v0[1] * v0[1]) + (v0[2] * v0[2] + v0[3] * v0[3])) + ((v1[0] * v1[0] + v1[1] * v1[1]) + (v1[2] * v1[2] + v1[3] * v1[3]));
                        ss += __shfl_xor(ss, 16); ss += __shfl_xor(ss, 32);
                        if (fq == 0) X[((ai * HALF + wr * 64 + m * 16 + fr) * 2 + bj) * 4 + wc] = ss; }
            asm volatile("s_waitcnt lgkmcnt(0)" ::: "memory"); __builtin_amdgcn_s_barrier(); asm volatile("" ::: "memory");
            const float qs = (u.pn < 2) ? 0.125f * 1.4426950408889634f : 1.0f;
            const PG8_GAS float* gp = qkg + (u.pn < 2 ? 0 : 64) + (wc & 1) * 32 + 8 * fq;
            const f32x4 g0 = *(const PG8_GAS f32x4*)gp, g1 = *(const PG8_GAS f32x4*)(gp + 4);
#pragma unroll
            for (int ai = 0; ai < 2; ++ai)
#pragma unroll
                for (int m = 0; m < 4; ++m) { PG8_GAS bf16_t* rowp = O + (size_t)(row0 + ai * HALF + m * 16) * ldc + col0;
#pragma unroll
                    for (int bj = 0; bj < 2; ++bj) { const PG8_LAS float* xp = X + ((ai * HALF + wr * 64 + m * 16 + fr) * 2 + bj) * 4;
                        const float tot = xp[wc] + xp[wc ^ 1], rn = (1.0f / sqrtf(tot * (1.0f / 64.0f) + 1e-6f)) * qs;
                        const f32x4 v0 = (acc[ai][bj][m][0] * rs[ai][m] + bv[bj][0]) * rn * g0, v1 = (acc[ai][bj][m][1] * rs[ai][m] + bv[bj][1]) * rn * g1;
                        u32x4 w; w.x = cvt_pk_bf16(v0[0], v0[1]); w.y = cvt_pk_bf16(v0[2], v0[3]); w.z = cvt_pk_bf16(v1[0], v1[1]); w.w = cvt_pk_bf16(v1[2], v1[3]);
                        *(PG8_GAS u32x4*)(rowp + bj * HALF) = w; } }
        } else if (u.pn < pn0) {
            const int col0 = u.pn * BM + wc * 32 + 8 * fq;
#pragma unroll
            for (int ai = 0; ai < 2; ++ai) if (ai < nai)
#pragma unroll
                for (int m = 0; m < 4; ++m) { PG8_GAS bf16_t* rowp = O + (size_t)(row0 + ai * HALF + m * 16) * ldc + col0;
#pragma unroll
                    for (int bj = 0; bj < 2; ++bj) { const f32x4 v0 = acc[ai][bj][m][0] * rs[ai][m] + bv[bj][0], v1 = acc[ai][bj][m][1] * rs[ai][m] + bv[bj][1];
                        u32x4 w; w.x = cvt_pk_bf16(v0[0], v0[1]); w.y = cvt_pk_bf16(v0[2], v0[3]); w.z = cvt_pk_bf16(v1[0], v1[1]); w.w = cvt_pk_bf16(v1[2], v1[3]);
                        *(PG8_GAS u32x4*)(rowp + bj * HALF) = w; } }
        } else {
            const int col0 = colbase + (u.pn - pn0) * HALF + wc * 32 + 8 * fq;
#pragma unroll
            for (int ai = 0; ai < 2; ++ai) if (ai < nai)
#pragma unroll
                for (int m = 0; m < 4; ++m) { PG8_GAS bf16_t* rowp = O + (size_t)(row0 + ai * HALF + m * 16) * ldc + col0;
                    f32x4 g0 = acc[ai][0][m][0] * rs[ai][m] + bv[0][0], g1 = acc[ai][0][m][1] * rs[ai][m] + bv[0][1]; const f32x4 u0 = acc[ai][1][m][0] * rs[ai][m] + bv[1][0], u1 = acc[ai][1][m][1] * rs[ai][m] + bv[1][1];
                    if (act_silu) {
#pragma unroll
                        for (int e = 0; e < 4; ++e) { g0[e] = silu_f(g0[e]); g1[e] = silu_f(g1[e]); } }
                    g0 = g0 * u0; g1 = g1 * u1;
                    u32x4 w; w.x = cvt_pk_bf16(g0[0], g0[1]); w.y = cvt_pk_bf16(g0[2], g0[3]); w.z = cvt_pk_bf16(g1[0], g1[1]); w.w = cvt_pk_bf16(g1[2], g1[3]);
                    *(PG8_GAS u32x4*)rowp = w; }
        }
    }
};
struct EpiRes {
    static constexpr bool PERM = true, AFTER_DRAIN = false;
    const PG8_LAS unsigned* P;
    static constexpr int gstride = 9216, rows_per_batch = 8192;
    static __device__ __forceinline__ void put(PG8_LAS unsigned* P, const float* base, float* out, const float* gate, float gs, const float* nxt_g, const float* nxt_scale, bf16_t* xg, float* rowss, int has_nxt) {
        lds_put(P, base); lds_put(P + 2, out); lds_put(P + 4, gate); lds_put(P + 6, nxt_g); lds_put(P + 8, nxt_scale); lds_put(P + 10, xg); lds_put(P + 12, rowss); P[14] = __float_as_uint(gs); P[15] = has_nxt; }
    __device__ __forceinline__ void operator()(const f32x4 (&acc)[2][2][4][2], const Unit& u, int wr, int wc, int fr, int fq) const {
        const PG8_GAS float* const base = (const PG8_GAS float*)lds_ptr<const float>(P); PG8_GAS float* const out = (PG8_GAS float*)lds_ptr<float>(P + 2); const PG8_GAS float* const gate = (const PG8_GAS float*)lds_ptr<const float>(P + 4);
        const PG8_GAS float* const nxt_g = (const PG8_GAS float*)lds_ptr<const float>(P + 6); const PG8_GAS float* const nxt_scale = (const PG8_GAS float*)lds_ptr<const float>(P + 8);
        PG8_GAS bf16_t* const xg = (PG8_GAS bf16_t*)lds_ptr<bf16_t>(P + 10); PG8_GAS float* const rowss = (PG8_GAS float*)lds_ptr<float>(P + 12);
        const float gs = __uint_as_float((unsigned)lds_int(P + 14)); const int has_nxt = lds_int(P + 15);
        const int row0 = u.pm * BM + wr * 64 + fr, col0 = u.pn * BM + wc * 32 + 8 * fq;
        const int b = (u.pm * BM) / rows_per_batch;
        const PG8_GAS float* gp = gate + (size_t)b * gstride + col0;
        f32x4 bx[3][2][2];
#define PG8_LDROW(it_, buf_) do { const size_t off_ = (size_t)(row0 + ((it_) >> 2) * HALF + ((it_) & 3) * 16) * 1024 + col0; \
            _Pragma("unroll") for (int bj = 0; bj < 2; ++bj) { bx[buf_][bj][0] = *(const PG8_GAS f32x4*)(base + off_ + bj * HALF); bx[buf_][bj][1] = *(const PG8_GAS f32x4*)(base + off_ + bj * HALF + 4); } } while (0)
        PG8_LDROW(0, 0); PG8_LDROW(1, 1);
        f32x4 gv[2][2], gm[2][2];
#pragma unroll
        for (int bj = 0; bj < 2; ++bj)
#pragma unroll
            for (int n = 0; n < 2; ++n) { gv[bj][n] = *(const PG8_GAS f32x4*)(gp + bj * HALF + 4 * n) * gs;
                gm[bj][n] = *(const PG8_GAS f32x4*)(nxt_g + col0 + bj * HALF + 4 * n) * (*(const PG8_GAS f32x4*)(nxt_scale + (size_t)b * gstride + col0 + bj * HALF + 4 * n) + 1.0f); }
#pragma unroll
        for (int it = 0; it < 8; ++it) { const int ai = it >> 2, m = it & 3; const int row = row0 + ai * HALF + m * 16; const size_t off = (size_t)row * 1024 + col0; float ss = 0.f;
            if (it + 2 < 8) PG8_LDROW(it + 2, (it + 2) % 3);
#pragma unroll
            for (int bj = 0; bj < 2; ++bj) {
                const f32x4 x0 = bx[it % 3][bj][0] + gv[bj][0] * acc[ai][bj][m][0], x1 = bx[it % 3][bj][1] + gv[bj][1] * acc[ai][bj][m][1];
                *(PG8_GAS f32x4*)(out + off + bj * HALF) = x0; *(PG8_GAS f32x4*)(out + off + bj * HALF + 4) = x1;
                if (has_nxt) { ss += ((x0[0] * x0[0] + x0[1] * x0[1]) + (x0[2] * x0[2] + x0[3] * x0[3])) + ((x1[0] * x1[0] + x1[1] * x1[1]) + (x1[2] * x1[2] + x1[3] * x1[3]));
                    const f32x4 y0 = x0 * gm[bj][0], y1 = x1 * gm[bj][1];
                    u32x4 w; w.x = cvt_pk_bf16(y0[0], y0[1]); w.y = cvt_pk_bf16(y0[2], y0[3]); w.z = cvt_pk_bf16(y1[0], y1[1]); w.w = cvt_pk_bf16(y1[2], y1[3]);
                    *(PG8_GAS u32x4*)(xg + off + bj * HALF) = w; } }
            if (has_nxt) { ss += __shfl_xor(ss, 16); ss += __shfl_xor(ss, 32); if (fq == 0) rowss[(size_t)row * 16 + u.pn * 4 + wc] = ss; } }
#undef PG8_LDROW
    }
};

template <class Epi, class Sched, bool ALIGN_EPI = false, bool SP2 = false>
__device__ __forceinline__ void gemm_phase(PG8_LAS unsigned char* lds, const Gemm g, const Sched& S, const Epi& E, const int tid_in) {
    int tid_o = tid_in; asm volatile("" : "+v"(tid_o));
    const int tid = tid_o, wid = __builtin_amdgcn_readfirstlane(tid >> 6), lane = tid & 63, wr = wid >> 2, wc = wid & 3, fr = lane & 15, fq = lane >> 4;
    const int K = g.K, nt = K / BK;
    unsigned voffA[2], voffB[2];
#pragma unroll
    for (int i = 0; i < 2; ++i) { int R, C; stage_rc(tid * 16 + i * 8192, R, C); const int Rb = Epi::PERM ? ((R & ~31) + perm32(R & 31)) : R;
        voffA[i] = (unsigned)(R * K + C) * 2u; voffB[i] = (g.blin & 1) ? (unsigned)(tid * 16 + i * 8192) : (unsigned)(Rb * K + C) * 2u; }
    const size_t kstep = (size_t)(BK * 2);
    const size_t kstepB = (g.blin & 1) ? (size_t)16384 : kstep;
    const size_t hstep = (size_t)HALF * K * 2;
    const size_t tstep = 2 * hstep;
    const unsigned ldsbase = (unsigned)__builtin_amdgcn_readfirstlane((int)(unsigned)(uintptr_t)lds);
    const unsigned ldsw = (unsigned)wid * 1024u;
    const int aoff = lds_byte(wr * 64 + fr, fq * 8), boff = lds_byte(wc * 32 + fr, fq * 8);
#define PG8_SA(b, h) (((b) * 2 + (h)) * HTB)
#define PG8_SB(b, h) ((4 + (b) * 2 + (h)) * HTB)
#define PG8_STAGE(bufoff, gbase, voff) do { _Pragma("unroll") for (int _i = 0; _i < 2; ++_i) { unsigned keep_; \
        asm volatile("s_mov_b32 %0, m0\n\ts_mov_b32 m0, %3\n\ts_nop 0\n\tglobal_load_lds_dwordx4 %1, %2\n\ts_mov_b32 m0, %0" : "=&s"(keep_) \
            : "v"((voff)[_i]), "s"((const char*)(gbase)), "s"(ldsbase + (unsigned)(bufoff) + ldsw + (unsigned)(_i * 8192)) : "memory"); } } while (0)
#define PG8_LDA(dst, b, h) do { _Pragma("unroll") for (int m = 0; m < 4; ++m) _Pragma("unroll") for (int k = 0; k < 2; ++k) dst[m][k] = *(const PG8_LAS bf16x8*)(lds + PG8_SA(b, h) + aoff + m * 2048 + k * 1024); } while (0)
#define PG8_LDB(dst, b, h) do { _Pragma("unroll") for (int n = 0; n < 2; ++n) _Pragma("unroll") for (int k = 0; k < 2; ++k) dst[n][k] = *(const PG8_LAS bf16x8*)(lds + PG8_SB(b, h) + boff + n * 2048 + k * 1024); } while (0)
#define PG8_MMA(ai, bj, At, Bt) do { __builtin_amdgcn_s_setprio(1); _Pragma("unroll") for (int m = 0; m < 4; ++m) _Pragma("unroll") for (int n = 0; n < 2; ++n) _Pragma("unroll") for (int k = 0; k < 2; ++k) \
        acc[ai][bj][m][n] = __builtin_amdgcn_mfma_f32_16x16x32_bf16(Bt[n][k], At[m][k], acc[ai][bj][m][n], 0, 0, 0); __builtin_amdgcn_s_setprio(0); } while (0)
#define PG8_WAIT_V(n) asm volatile("s_waitcnt vmcnt(" #n ")" ::: "memory")
#define PG8_WAIT_L(n) asm volatile("s_waitcnt lgkmcnt(" #n ")" ::: "memory")
#define PG8_BAR __builtin_amdgcn_s_barrier()
#define PG8_SCHED __builtin_amdgcn_sched_barrier(0)
    Unit cur, nxt; int ui = 0;
    if (!S.next(0, cur)) return;
    f32x4 acc[2][2][4][2];
#pragma unroll
    for (int a = 0; a < 2; ++a)
#pragma unroll
        for (int b = 0; b < 2; ++b)
#pragma unroll
            for (int m = 0; m < 4; ++m)
#pragma unroll
                for (int n = 0; n < 2; ++n) acc[a][b][m][n] = (f32x4){0.f, 0.f, 0.f, 0.f};
    bf16x8 At[4][2], B0[2][2], B1[2][2];
    const char* cA = (const char*)g.A + (size_t)cur.pm * tstep + (size_t)cur.half * hstep; const char* cB = (const char*)g.Bt + (size_t)cur.pn * tstep;
    S.a_ready(cur);
    if constexpr (SP2) {
        PG8_STAGE(PG8_SB(0, 0), cB, voffB); PG8_STAGE(PG8_SB(0, 1), cB + hstep, voffB); PG8_STAGE(PG8_SA(0, 0), cA, voffA); PG8_STAGE(PG8_SA(0, 1), cA + hstep, voffA);
        if (wr == 1) PG8_BAR;
        PG8_WAIT_V(2); PG8_BAR;
        PG8_STAGE(PG8_SB(1, 0), cB + kstepB, voffB); PG8_STAGE(PG8_SA(1, 0), cA + kstep, voffA); PG8_STAGE(PG8_SB(1, 1), cB + hstep + kstepB, voffB);
        PG8_WAIT_V(6); PG8_BAR;
    } else {
        PG8_STAGE(PG8_SB(0, 0), cB, voffB); PG8_STAGE(PG8_SA(0, 0), cA, voffA); PG8_STAGE(PG8_SB(0, 1), cB + hstep, voffB); PG8_STAGE(PG8_SA(0, 1), cA + hstep, voffA);
        if (wr == 1) PG8_BAR;
        PG8_WAIT_V(4); PG8_BAR;
        PG8_STAGE(PG8_SB(1, 0), cB + kstepB, voffB); PG8_STAGE(PG8_SA(1, 0), cA + kstep, voffA); PG8_STAGE(PG8_SB(1, 1), cB + hstep + kstepB, voffB);
        PG8_WAIT_V(6); PG8_BAR;
    }
    for (;;) {
        const bool has_next = S.next(ui + 1, nxt);
        const char* nA = has_next ? (const char*)g.A + (size_t)nxt.pm * tstep + (size_t)nxt.half * hstep : cA; const char* nB = has_next ? (const char*)g.Bt + (size_t)nxt.pn * tstep : cB;
        const bool narrow_u = cur.narrow != 0;
        for (int t = 0; t < nt; t += 2) {
            const bool last = (t == nt - 2);
            const char* a1 = cA + (size_t)(t + 1) * kstep;
            const char* a2 = last ? nA : cA + (size_t)(t + 2) * kstep; const char* b2 = last ? nB : cB + (size_t)(t + 2) * kstepB;
            const char* a3 = a2 + kstep; const char* b3 = b2 + kstepB;
            if (last && has_next) S.a_ready(nxt);
            if constexpr (SP2) {
            PG8_LDB(B0, 0, 0); PG8_LDB(B1, 0, 1); PG8_SCHED; PG8_LDA(At, 0, 0); PG8_STAGE(PG8_SA(1, 1), a1 + hstep, voffA);
            PG8_WAIT_V(8); PG8_WAIT_L(0); PG8_BAR; PG8_MMA(0, 0, At, B0); PG8_MMA(0, 1, At, B1); PG8_BAR; PG8_SCHED;
            PG8_LDA(At, 0, 1); PG8_STAGE(PG8_SB(0, 0), b2, voffB); PG8_STAGE(PG8_SB(0, 1), b2 + hstep, voffB); PG8_STAGE(PG8_SA(0, 0), a2, voffA);
            PG8_WAIT_V(8); PG8_WAIT_L(0); PG8_BAR; if (!narrow_u) { PG8_MMA(1, 0, At, B0); PG8_MMA(1, 1, At, B1); } PG8_BAR; PG8_SCHED;
            PG8_LDB(B0, 1, 0); PG8_LDB(B1, 1, 1); PG8_SCHED; PG8_LDA(At, 1, 0); PG8_STAGE(PG8_SA(0, 1), a2 + hstep, voffA);
            PG8_WAIT_V(8); PG8_WAIT_L(0); PG8_BAR; PG8_MMA(0, 0, At, B0); PG8_MMA(0, 1, At, B1); PG8_BAR; PG8_SCHED;
            PG8_LDA(At, 1, 1); PG8_STAGE(PG8_SB(1, 0), b3, voffB); PG8_STAGE(PG8_SB(1, 1), b3 + hstep, voffB); PG8_STAGE(PG8_SA(1, 0), a3, voffA);
            PG8_WAIT_V(8); PG8_WAIT_L(0); PG8_BAR; if (!narrow_u) { PG8_MMA(1, 0, At, B0); PG8_MMA(1, 1, At, B1); } PG8_BAR; PG8_SCHED;
            } else {
            PG8_LDB(B0, 0, 0); PG8_SCHED; PG8_LDA(At, 0, 0); PG8_STAGE(PG8_SA(1, 1), a1 + hstep, voffA);
            PG8_WAIT_L(8); PG8_BAR; PG8_WAIT_L(0); PG8_MMA(0, 0, At, B0); PG8_BAR; PG8_SCHED;
            PG8_LDB(B1, 0, 1); PG8_STAGE(PG8_SB(0, 0), b2, voffB);
            PG8_BAR; PG8_WAIT_L(0); PG8_MMA(0, 1, At, B1); PG8_BAR;
            PG8_LDA(At, 0, 1); PG8_STAGE(PG8_SA(0, 0), a2, voffA);
            PG8_BAR; PG8_WAIT_L(0); PG8_MMA(1, 0, At, B0); PG8_BAR; PG8_SCHED;
            PG8_STAGE(PG8_SB(0, 1), b2 + hstep, voffB);
            PG8_WAIT_V(6); PG8_BAR; PG8_MMA(1, 1, At, B1); PG8_BAR;
            PG8_LDB(B0, 1, 0); PG8_SCHED; PG8_LDA(At, 1, 0); PG8_STAGE(PG8_SA(0, 1), a2 + hstep, voffA);
            PG8_WAIT_L(8); PG8_BAR; PG8_WAIT_L(0); PG8_MMA(0, 0, At, B0); PG8_BAR; PG8_SCHED;
            PG8_LDB(B1, 1, 1); PG8_STAGE(PG8_SB(1, 0), b3, voffB);
            PG8_BAR; PG8_WAIT_L(0); PG8_MMA(0, 1, At, B1); PG8_BAR;
            PG8_LDA(At, 1, 1); PG8_STAGE(PG8_SA(1, 0), a3, voffA);
            PG8_BAR; PG8_WAIT_L(0); PG8_MMA(1, 0, At, B0); PG8_BAR; PG8_SCHED;
            PG8_STAGE(PG8_SB(1, 1), b3 + hstep, voffB);
            PG8_WAIT_V(6); PG8_BAR; PG8_MMA(1, 1, At, B1); PG8_BAR;
            }
        }
        if constexpr (ALIGN_EPI) { if (wr == 0) PG8_BAR; }
        if constexpr (!Epi::AFTER_DRAIN) { E(acc, cur, wr, wc, fr, fq); S.done(cur); }
        if (!has_next) break;
#pragma unroll
        for (int a = 0; a < 2; ++a)
#pragma unroll
            for (int b = 0; b < 2; ++b)
#pragma unroll
                for (int m = 0; m < 4; ++m)
#pragma unroll
                    for (int n = 0; n < 2; ++n) acc[a][b][m][n] = (f32x4){0.f, 0.f, 0.f, 0.f};
        cur = nxt; cA = nA; cB = nB; ++ui;
        if constexpr (ALIGN_EPI) { if (wr == 1) PG8_BAR; }
    }
    PG8_WAIT_V(0);
    if constexpr (!ALIGN_EPI) { if (wr == 0) PG8_BAR; }
    PG8_BAR;
    if constexpr (Epi::AFTER_DRAIN) { E.fused(acc, cur, wr, wc, fr, fq, lds, wid, lane); S.done(cur); }
#undef PG8_SA
#undef PG8_SB
#undef PG8_STAGE
#undef PG8_LDA
#undef PG8_LDB
#undef PG8_MMA
#undef PG8_WAIT_V
#undef PG8_WAIT_L
#undef PG8_BAR
#undef PG8_SCHED
}
}
#ifndef PROBE_BLIN
#define PROBE_BLIN 0
#endif
#ifndef PROBE_ATT
#define PROBE_ATT 0
#endif
#ifndef PROBE
#define PROBE 0
#endif
#define LAS __attribute__((address_space(3)))
typedef unsigned short bf16;
typedef short bf16x8 __attribute__((ext_vector_type(8)));
typedef short s16x4 __attribute__((ext_vector_type(4)));
typedef short v4i16_t __attribute__((ext_vector_type(4)));
typedef float f32x4 __attribute__((ext_vector_type(4)));
typedef float f32x16 __attribute__((ext_vector_type(16)));
typedef unsigned u32x4 __attribute__((ext_vector_type(4)));
typedef unsigned u32x2 __attribute__((ext_vector_type(2)));

constexpr int NWAVES = 8, NTHR = 512;
constexpr int BATCH = 2, SEQ = 8192, DM = 1024, FF = 2816, M = BATCH * SEQ, NMOD = 9 * DM;
constexpr float EPS = 1e-6f;
constexpr size_t MiB = 1u << 20;
constexpr size_t WS_MOD = 1 * MiB;
constexpr size_t WS_WGU = 2 * MiB;
constexpr size_t WS_WD = WS_WGU + 8 * 11 * MiB;
constexpr size_t WS_WINAB = WS_WD + 44 * MiB;
constexpr size_t WS_WOUTAB = WS_WINAB + 8 * MiB;
constexpr size_t WS_WINC = WS_WOUTAB + 4 * MiB;
constexpr size_t WS_WOUTC = WS_WINC + 12 * MiB;
constexpr size_t WS_H = WS_WOUTC + 4 * MiB;
constexpr size_t WS_MIX = WS_H + 32 * MiB;
constexpr size_t WS_ACT = WS_MIX + 32 * MiB;
constexpr size_t WS_ROWSS = WS_ACT + 96 * MiB;
constexpr size_t WS_BIAS = WS_ROWSS + 1 * MiB;
constexpr size_t WS_END = WS_BIAS + 1 * MiB;
constexpr int BIAS_L = 28672, BIAS_MIX = 11264, BIAS_F2 = 17408;
constexpr int LDS_BYTES = 147456;

__device__ __forceinline__ unsigned pk2(float lo, float hi) { return pg8::cvt_pk_bf16(lo, hi); }
__device__ __forceinline__ float bflo(unsigned w) { return __uint_as_float(w << 16); }
__device__ __forceinline__ float bfhi(unsigned w) { return __uint_as_float(w & 0xffff0000u); }
__device__ __forceinline__ float wave_sum(float v) {
#pragma unroll
    for (int o = 1; o < 64; o <<= 1) v += __shfl_xor(v, o);
    return v;
}
__device__ __forceinline__ int fresh_tid(int wave0) { unsigned ones = ~0u; asm volatile("" : "+s"(ones)); int t = wave0 * 64 + (int)__builtin_amdgcn_mbcnt_hi(ones, __builtin_amdgcn_mbcnt_lo(ones, 0u)); asm volatile("" : "+v"(t)); return t; }
struct Args { const float* in[21]; float* out; unsigned char* ws; int ph_lo, ph_hi; };
typedef const Args __attribute__((address_space(4)))* KArgs;

__device__ __forceinline__ void tr_flush(bf16* WT, int ldk, int k0, int drow0, LAS float* scr, int lane) {
    asm volatile("s_waitcnt lgkmcnt(0)" ::: "memory");
    const int c = lane & 7;
#pragma unroll
    for (int j = 0; j < 4; ++j) { const int n = (lane >> 3) + 8 * j; const LAS float* s = scr + (8 * c) * 33 + n;
        u32x4 o; o.x = pk2(s[0 * 33], s[1 * 33]); o.y = pk2(s[2 * 33], s[3 * 33]); o.z = pk2(s[4 * 33], s[5 * 33]); o.w = pk2(s[6 * 33], s[7 * 33]);
        *(u32x4*)(WT + (size_t)(drow0 + n) * ldk + k0 + 8 * c) = o; }
    asm volatile("s_waitcnt lgkmcnt(0)" ::: "memory");
}
__device__ __forceinline__ void tr_item(const float* W, int ldn, int k0, int n0, bf16* WT, int ldk, int drow0, LAS float* scr, int lane) {
    float tv[32];
    const float* wp = W + (size_t)(k0 + (lane >> 5)) * ldn + n0 + (lane & 31);
#pragma unroll
    for (int i = 0; i < 32; ++i) tv[i] = wp[(size_t)(2 * i) * ldn];
#pragma unroll
    for (int i = 0; i < 32; ++i) scr[(2 * i + (lane >> 5)) * 33 + (lane & 31)] = tv[i];
    tr_flush(WT, ldk, k0, drow0, scr, lane);
}
__device__ __forceinline__ int glu_row(int f, int up) { return 256 * (f >> 7) + (f & 127) + (up ? 128 : 0); }

__device__ __forceinline__ void prep_phase(KArgs Ap, LAS unsigned char* lds, int tid, int lane, int wave) {
#define A (*Ap)
    const int G = gridDim.x, gw = blockIdx.x * NWAVES + wave, NGW = G * NWAVES;
    bf16* const WGU = (bf16*)(A.ws + WS_WGU); bf16* const WD = (bf16*)(A.ws + WS_WD); bf16* const WINAB = (bf16*)(A.ws + WS_WINAB);
    bf16* const WOUTAB = (bf16*)(A.ws + WS_WOUTAB); bf16* const WINC = (bf16*)(A.ws + WS_WINC); bf16* const WOUTC = (bf16*)(A.ws + WS_WOUTC);
    {
        LAS float* ca = (LAS float*)(lds);
        LAS float* red = (LAS float*)(lds + 8192);
        for (int i = tid; i < 2 * DM; i += NTHR) { const float v = A.in[1][i]; ca[i] = v / (1.0f + __expf(-v)); }
        __syncthreads();
        float* mod = (float*)(A.ws + WS_MOD);
        for (int task = blockIdx.x; task < 4 * 288; task += G) {
            const int l = task / 288, cgp = task % 288, col = lane & 31, par = lane >> 5;
            const float* wp = A.in[3] + (size_t)l * DM * NMOD + (size_t)(wave * 128 + par) * NMOD + cgp * 32 + col;
            float a0 = 0.f, a1 = 0.f;
#pragma unroll 16
            for (int k = 0; k < 64; ++k) { const float w = wp[(size_t)(2 * k) * NMOD]; a0 += ca[wave * 128 + 2 * k + par] * w; a1 += ca[DM + wave * 128 + 2 * k + par] * w; }
            a0 += __shfl_xor(a0, 32); a1 += __shfl_xor(a1, 32);
            if (lane < 32) { red[(wave * 2 + 0) * 32 + lane] = a0; red[(wave * 2 + 1) * 32 + lane] = a1; }
            __syncthreads();
            if (tid < 64) { const int b = tid >> 5, c = tid & 31; float s = 0.f;
#pragma unroll
                for (int w = 0; w < 8; ++w) s += red[(w * 2 + b) * 32 + c];
                mod[(size_t)(l * 2 + b) * NMOD + cgp * 32 + c] = s + A.in[4][(size_t)l * NMOD + cgp * 32 + c]; }
            __syncthreads();
        }
    }
    LAS float* scr = (LAS float*)(lds + wave * 16384);
    constexpr int N_FFN = 8 * 4224, N_INAB = 2 * 1024, N_OUTAB = 2 * 256, N_POOL = 2 * 256, N_INC = 2 * 1536, N_OUTC = 2 * 512;
    constexpr int NITEMS = N_FFN + N_INAB + N_OUTAB + N_POOL + N_INC + N_OUTC;
    for (int it = gw; it < NITEMS; it += NGW) {
        int r = it;
        if (r < N_FFN) { const int lj = r / 4224, q = r % 4224, which = q / 1408, q2 = q % 1408;
            if (which < 2) { const int kb = q2 / 88, nb = q2 % 88, f0 = 32 * nb;
                tr_item((which == 0 ? A.in[5] : A.in[6]) + (size_t)lj * DM * FF, FF, 64 * kb, f0, WGU + (size_t)lj * 5632 * 1024, 1024, glu_row(f0, which), scr, lane); }
            else { const int kb = q2 / 32, nb = q2 % 32; tr_item(A.in[7] + (size_t)lj * FF * DM, DM, 64 * kb, 32 * nb, WD + (size_t)lj * 1024 * FF, FF, 32 * nb, scr, lane); }
            continue; }
        r -= N_FFN;
        if (r < N_INAB) { const int e = r / 1024, q = r % 1024, kb = q / 64, nb = q % 64;
            tr_item(A.in[8] + (size_t)e * DM * 2048, 2048, 64 * kb, 32 * nb, WINAB + (size_t)e * 2048 * 1024, 1024, 32 * nb, scr, lane); continue; }
        r -= N_INAB;
        if (r < N_OUTAB) { const int e = r / 256, q = r % 256, kb = q / 32, nb = q % 32;
            tr_item(A.in[17] + (size_t)e * DM * DM, DM, 64 * kb, 32 * nb, WOUTAB + (size_t)e * DM * DM, DM, 32 * nb, scr, lane); continue; }
        r -= N_OUTAB;
        if (r < N_POOL) {
            const int e = r / 256, q = r % 256, kb = q / 32, nb = q % 32, g = kb >> 1, c0 = (kb & 1) * 64, n0 = 32 * nb;
            const float* pw = A.in[15] + ((size_t)(e * 4 + g) * 128 + c0 + lane) * 128;
            const float* ps = A.in[16] + e * 512 + g * 128;
            const float* wo = A.in[17] + (size_t)e * DM * DM + (size_t)(512 + g * 128) * DM + n0;
            float acc[32];
#pragma unroll
            for (int n = 0; n < 32; ++n) acc[n] = 0.f;
            for (int d = 0; d < 128; ++d) { const float pv = pw[d] * ps[d]; const float* wr = wo + (size_t)d * DM;
#pragma unroll
                for (int n = 0; n < 32; ++n) acc[n] += pv * wr[n]; }
#pragma unroll
            for (int n = 0; n < 32; ++n) scr[lane * 33 + n] = acc[n];
            tr_flush(WOUTAB + (size_t)e * DM * DM, DM, 512 + 64 * kb, n0, scr, lane); continue; }
        r -= N_POOL;
        if (r < N_INC) { const int o = r / 1536, q = r % 1536, kb = q / 96, nb = q % 96, c0 = 32 * nb;
            const int drow = c0 < 1024 ? c0 : (c0 < 2048 ? 1024 + glu_row(c0 - 1024, 0) : 1024 + glu_row(c0 - 2048, 1));
            tr_item(A.in[18] + (size_t)o * DM * 3072, 3072, 64 * kb, c0, WINC + (size_t)o * 3072 * 1024, 1024, drow, scr, lane); continue; }
        r -= N_INC;
        { const int o = r / 512, q = r % 512, kb = q / 32, nb = q % 32;
            tr_item(A.in[20] + (size_t)o * DM * DM, DM, 64 * kb, 32 * nb, WOUTC + (size_t)o * DM * DM, DM, 32 * nb, scr, lane); }
    }
}

#undef A
__device__ __forceinline__ void prep2_phase(KArgs Ap, int lane, int wave) {
#define A (*Ap)
    const int gw = blockIdx.x * NWAVES + wave, NGW = gridDim.x * NWAVES;
    const float* mod = (const float*)(A.ws + WS_MOD); float* bias = (float*)(A.ws + WS_BIAS);
    constexpr int ROWS_L = 5632 + 3072 + 5632, ITEMS_L = ROWS_L / 32;
    for (int it = gw; it < 4 * ITEMS_L; it += NGW) {
        const int l = it / ITEMS_L, r32 = (it % ITEMS_L) * 32, e = l >> 1;
        int j, n0, N; const bf16* W;
        if (r32 < 5632) { j = 0; n0 = r32; N = 5632; W = (const bf16*)(A.ws + WS_WGU) + (size_t)(l * 2) * 5632 * 1024; }
        else if (r32 < 5632 + 3072) { j = 1; n0 = r32 - 5632; N = (l & 1) ? 3072 : 2048; if (n0 >= N) continue;
            W = (l & 1) ? (const bf16*)(A.ws + WS_WINC) + (size_t)e * 3072 * 1024 : (const bf16*)(A.ws + WS_WINAB) + (size_t)e * 2048 * 1024; }
        else { j = 2; n0 = r32 - 5632 - 3072; N = 5632; W = (const bf16*)(A.ws + WS_WGU) + (size_t)(l * 2 + 1) * 5632 * 1024; }
        const float* sh0 = mod + (size_t)(l * 2) * NMOD + (3 * j) * DM + 16 * lane; const float* sh1 = sh0 + NMOD;
        float s0[16], s1[16];
#pragma unroll
        for (int q = 0; q < 4; ++q) { const f32x4 a = ((const f32x4*)sh0)[q], b = ((const f32x4*)sh1)[q];
            s0[4 * q] = a.x; s0[4 * q + 1] = a.y; s0[4 * q + 2] = a.z; s0[4 * q + 3] = a.w; s1[4 * q] = b.x; s1[4 * q + 1] = b.y; s1[4 * q + 2] = b.z; s1[4 * q + 3] = b.w; }
        float* bo = bias + (size_t)l * BIAS_L + (j == 0 ? 0 : (j == 1 ? BIAS_MIX : BIAS_F2));
        for (int rr = 0; rr < 32; rr += 4) {
            u32x4 w0[4], w1[4];
#pragma unroll
            for (int u = 0; u < 4; ++u) { const u32x4* wp = (const u32x4*)(W + (size_t)(n0 + rr + u) * 1024 + 16 * lane); w0[u] = wp[0]; w1[u] = wp[1]; }
#pragma unroll
            for (int u = 0; u < 4; ++u) {
                const unsigned ww[8] = {w0[u].x, w0[u].y, w0[u].z, w0[u].w, w1[u].x, w1[u].y, w1[u].z, w1[u].w};
                float a0 = 0.f, a1 = 0.f;
#pragma unroll
                for (int q = 0; q < 8; ++q) { const float lo = bflo(ww[q]), hi = bfhi(ww[q]); a0 += s0[2 * q] * lo + s0[2 * q + 1] * hi; a1 += s1[2 * q] * lo + s1[2 * q + 1] * hi; }
                a0 = wave_sum(a0); a1 = wave_sum(a1);
                if (lane == 0) { bo[n0 + rr + u] = a0; bo[N + n0 + rr + u] = a1; }
            }
        }
    }
    const float* g = A.in[2]; bf16* xg = (bf16*)(A.ws + WS_H); float* rowss = (float*)(A.ws + WS_ROWSS);
    for (int m0 = gw; m0 < M; m0 += 4 * NGW) {
        f32x4 v[4][4];
#pragma unroll
        for (int k4 = 0; k4 < 4; ++k4) { const int m = (m0 + k4 * NGW < M) ? m0 + k4 * NGW : m0; const f32x4* xr = (const f32x4*)(A.in[0] + (size_t)m * DM) + lane;
#pragma unroll
            for (int j = 0; j < 4; ++j) v[k4][j] = xr[64 * j]; }
#pragma unroll
        for (int k4 = 0; k4 < 4; ++k4) { const int m = m0 + k4 * NGW; if (m >= M) break;
            const int b = m / SEQ; const float* sc = mod + (size_t)b * NMOD + DM;
            u32x2* o8 = (u32x2*)(xg + (size_t)m * DM) + lane; float s = 0.f;
#pragma unroll
            for (int j = 0; j < 4; ++j) { const f32x4 vv = v[k4][j]; s += (vv.x * vv.x + vv.y * vv.y) + (vv.z * vv.z + vv.w * vv.w);
                const f32x4 y = vv * ((const f32x4*)g)[lane + 64 * j] * (((const f32x4*)sc)[lane + 64 * j] + 1.0f);
                u32x2 w; w.x = pk2(y.x, y.y); w.y = pk2(y.z, y.w); o8[64 * j] = w; }
            s = wave_sum(s);
            if (lane < 16) rowss[(size_t)m * 16 + lane] = (lane == 0) ? s : 0.f; }
    }
}
#undef A
__device__ __forceinline__ void pool_phase(const bf16* proj  , bf16* mix, int lane, int wave) {
    const int gw = blockIdx.x * NWAVES + wave, NGW = gridDim.x * NWAVES;
    const int g = lane >> 4, w = 2 << g;
    for (int m = gw; m < M; m += NGW) {
        const int t = m % SEQ;
        const bf16* up = proj + (size_t)m * 2048 + 1536 + 8 * lane;
        const u32x4 c = *(const u32x4*)up;
        float s[8] = {bflo(c.x), bfhi(c.x), bflo(c.y), bfhi(c.y), bflo(c.z), bfhi(c.z), bflo(c.w), bfhi(c.w)};
        float cur[8];
#pragma unroll
        for (int e = 0; e < 8; ++e) cur[e] = s[e];
        const int cnt = (t + 1 < w) ? t + 1 : w;
        u32x4 pv[15];
#pragma unroll
        for (int j = 1; j < 16; ++j) { pv[j - 1] = (u32x4){0u, 0u, 0u, 0u}; if (j < cnt) pv[j - 1] = *(const u32x4*)(up - (size_t)j * 2048); }
#pragma unroll
        for (int j = 0; j < 15; ++j) { const u32x4 p = pv[j];
            s[0] += bflo(p.x); s[1] += bfhi(p.x); s[2] += bflo(p.y); s[3] += bfhi(p.y); s[4] += bflo(p.z); s[5] += bfhi(p.z); s[6] += bflo(p.w); s[7] += bfhi(p.w); }
        const float inv = 1.0f / (float)cnt;
        u32x4 o; o.x = pk2(s[0] * inv - cur[0], s[1] * inv - cur[1]); o.y = pk2(s[2] * inv - cur[2], s[3] * inv - cur[3]);
        o.z = pk2(s[4] * inv - cur[4], s[5] * inv - cur[5]); o.w = pk2(s[6] * inv - cur[6], s[7] * inv - cur[7]);
        *(u32x4*)(mix + (size_t)m * DM + 512 + 8 * lane) = o;
    }
}

__device__ __forceinline__ void conv_phase(const bf16* __restrict__ proj  , bf16* __restrict__ mix, const float* __restrict__ cw  , int tid) {
    const int gt = blockIdx.x * NTHR + tid, NGT = gridDim.x * NTHR;
    for (int i0 = gt; i0 < M * 128; i0 += 4 * NGT)
#pragma unroll
    for (int k4 = 0; k4 < 4; ++k4) { const int i = i0 + k4 * NGT; if (i >= M * 128) break;
        const int m = i >> 7, c8 = (i & 127) * 8, t = m % SEQ;
        const bf16* bp = proj + (size_t)m * 2048 + c8; const bf16* vp = bp + 1024;
        const u32x4 bb = *(const u32x4*)bp, v0 = *(const u32x4*)vp;
        u32x4 v1 = (u32x4){0u, 0u, 0u, 0u}, v2 = (u32x4){0u, 0u, 0u, 0u};
        if (t >= 1) v1 = *(const u32x4*)(vp - 2048);
        if (t >= 2) v2 = *(const u32x4*)(vp - 4096);
        const f32x4 w0a = *(const f32x4*)(cw + c8), w0b = *(const f32x4*)(cw + c8 + 4), w1a = *(const f32x4*)(cw + 1024 + c8), w1b = *(const f32x4*)(cw + 1024 + c8 + 4),
                    w2a = *(const f32x4*)(cw + 2048 + c8), w2b = *(const f32x4*)(cw + 2048 + c8 + 4);
        float y[8];
#define CV(e, W0, W1, W2, word, HI) y[e] = (HI ? bfhi(bb.word) : bflo(bb.word)) * (W0 * (HI ? bfhi(v2.word) : bflo(v2.word)) + W1 * (HI ? bfhi(v1.word) : bflo(v1.word)) + W2 * (HI ? bfhi(v0.word) : bflo(v0.word)))
        CV(0, w0a.x, w1a.x, w2a.x, x, 0); CV(1, w0a.y, w1a.y, w2a.y, x, 1); CV(2, w0a.z, w1a.z, w2a.z, y, 0); CV(3, w0a.w, w1a.w, w2a.w, y, 1);
        CV(4, w0b.x, w1b.x, w2b.x, z, 0); CV(5, w0b.y, w1b.y, w2b.y, z, 1); CV(6, w0b.z, w1b.z, w2b.z, w, 0); CV(7, w0b.w, w1b.w, w2b.w, w, 1);
#undef CV
        u32x4 o; o.x = pk2(y[0], y[1]); o.y = pk2(y[2], y[3]); o.z = pk2(y[4], y[5]); o.w = pk2(y[6], y[7]);
        *(u32x4*)(mix + (size_t)m * DM + c8) = o;
    }
}

__device__ __forceinline__ void qknorm_phase(const bf16* proj, bf16* qkn  , const float* qkg  , int lane, int wave) {
    const int gw = blockIdx.x * NWAVES + wave, NGW = gridDim.x * NWAVES;
    const int isk = lane >> 5;
    const float* g = qkg + isk * 64 + ((16 * lane) & 63);
    float gv[16];
#pragma unroll
    for (int q = 0; q < 4; ++q) { const f32x4 a = ((const f32x4*)g)[q]; gv[4 * q] = a.x; gv[4 * q + 1] = a.y; gv[4 * q + 2] = a.z; gv[4 * q + 3] = a.w; }
    const float qs = isk ? 1.0f : 0.125f * 1.4426950408889634f;
    for (int m = gw; m < M; m += NGW) {
        const u32x4* p = (const u32x4*)(proj + (size_t)m * 2048 + 16 * lane); u32x4* po = (u32x4*)(qkn + (size_t)m * 1024 + 16 * lane);
        const u32x4 w0 = p[0], w1 = p[1];
        const unsigned ww[8] = {w0.x, w0.y, w0.z, w0.w, w1.x, w1.y, w1.z, w1.w};
        float f[16], ss = 0.f;
#pragma unroll
        for (int q = 0; q < 8; ++q) { f[2 * q] = bflo(ww[q]); f[2 * q + 1] = bfhi(ww[q]); ss += f[2 * q] * f[2 * q] + f[2 * q + 1] * f[2 * q + 1]; }
        ss += __shfl_xor(ss, 1); ss += __shfl_xor(ss, 2);
        const float rstd = (1.0f / sqrtf(ss * (1.0f / 64.0f) + EPS)) * qs;
        u32x4 o0, o1;
        o0.x = pk2(f[0] * rstd * gv[0], f[1] * rstd * gv[1]); o0.y = pk2(f[2] * rstd * gv[2], f[3] * rstd * gv[3]); o0.z = pk2(f[4] * rstd * gv[4], f[5] * rstd * gv[5]); o0.w = pk2(f[6] * rstd * gv[6], f[7] * rstd * gv[7]);
        o1.x = pk2(f[8] * rstd * gv[8], f[9] * rstd * gv[9]); o1.y = pk2(f[10] * rstd * gv[10], f[11] * rstd * gv[11]); o1.z = pk2(f[12] * rstd * gv[12], f[13] * rstd * gv[13]); o1.w = pk2(f[14] * rstd * gv[14], f[15] * rstd * gv[15]);
        po[0] = o0; po[1] = o1;
    }
}

namespace att {
constexpr int STAGE = 32768, NSTAGE = 4, OFF_V = 16384, OFF_WS = 131072 + 1024;
__device__ __forceinline__ int crow(int i, int h) { return (i & 3) + 8 * (i >> 2) + 4 * h; }
__device__ __forceinline__ s16x4 vtr(const LAS unsigned char* p) { return __builtin_bit_cast(s16x4, __builtin_amdgcn_ds_read_tr16_b64_v4i16((LAS v4i16_t*)p)); }
#define MFMA32(a, b, c) __builtin_amdgcn_mfma_f32_32x32x16_bf16((a), (b), (c), 0, 0, 0)
__device__ __forceinline__ float max3f(float a, float b, float c) { float r; asm("v_max3_f32 %0, %1, %2, %3" : "=v"(r) : "v"(a), "v"(b), "v"(c)); return r; }
__device__ __forceinline__ float max2f(float a, float b) { float r; asm("v_max_f32_e32 %0, %1, %2" : "=v"(r) : "v"(a), "v"(b)); return r; }
__device__ __forceinline__ void glds16(const void* gsrc, unsigned lds_dst) { unsigned keep;
    asm volatile("s_mov_b32 %0, m0\n\ts_mov_b32 m0, %2\n\ts_nop 0\n\tglobal_load_lds_dwordx4 %1, off\n\ts_mov_b32 m0, %0" : "=&s"(keep) : "v"(gsrc), "s"(lds_dst) : "memory"); }
#define GLDS16(gp, lp) glds16((gp), (unsigned)__builtin_amdgcn_readfirstlane((int)(unsigned)(uintptr_t)(lp)))
__device__ __forceinline__ void glds16s(const void* sbase, unsigned voff, unsigned lds_dst) { unsigned keep;
    asm volatile("s_mov_b32 %0, m0\n\ts_mov_b32 m0, %3\n\ts_nop 0\n\tglobal_load_lds_dwordx4 %1, %2\n\ts_mov_b32 m0, %0" : "=&s"(keep) : "v"(voff), "s"(sbase), "s"(lds_dst) : "memory"); }
__device__ __forceinline__ void dma_tile(LAS unsigned char* st, const bf16* proj, const bf16* qkn, size_t rowbase, int hd, int t, int wid, unsigned koff, unsigned voff) {
    const unsigned ldsb = (unsigned)__builtin_amdgcn_readfirstlane((int)(unsigned)(uintptr_t)st);
    const char* kb = (const char*)(qkn + (rowbase + (size_t)(64 * t)) * 2048 + 512 + hd * 128 + 8 * wid);
    glds16s(kb, koff, ldsb + wid * 1024);
    glds16s(kb + 128, koff, ldsb + 8192 + wid * 1024);
#pragma unroll
    for (int i = 0; i < 2; ++i) { const int s = 2 * wid + i, db = s >> 2, kvg = s & 3;
        const char* vb = (const char*)(proj + (rowbase + (size_t)(64 * t + 16 * kvg)) * 2048 + 1024 + hd * 128 + 32 * db);
        glds16s(vb, voff, ldsb + OFF_V + s * 1024); }
}

template <bool MASKED> __device__ __forceinline__ void s_step(const LAS unsigned char* kb, const bf16x8 (&qr)[4], f32x16& negm, float& mref, f32x16 (&o)[4], float& lsum, bf16x8 (&pa)[4],
                                                            LAS float* wsf, int r, int h, int thr, bool first) {
    f32x16 p0, p1;
    bf16x8 ka[4], kc[4];
#pragma unroll
    for (int d0 = 0; d0 < 4; ++d0) { ka[d0] = *(const LAS bf16x8*)(kb + d0 * 2048); kc[d0] = *(const LAS bf16x8*)(kb + d0 * 2048 + 512); }
    __builtin_amdgcn_sched_barrier(0);
    __builtin_amdgcn_s_setprio(1);
    p0 = MFMA32(ka[0], qr[0], negm); p1 = MFMA32(kc[0], qr[0], negm);
#pragma unroll
    for (int d0 = 1; d0 < 4; ++d0) { p0 = MFMA32(ka[d0], qr[d0], p0); p1 = MFMA32(kc[d0], qr[d0], p1); }
    __builtin_amdgcn_s_setprio(0);
    if (MASKED) {
#pragma unroll
        for (int i = 0; i < 16; ++i) { const int kl = crow(i, h); if (kl > thr) p0[i] = -INFINITY; if (kl + 32 > thr) p1[i] = -INFINITY; } }
    asm volatile("s_nop 15\n\ts_nop 7" : "+v"(p0), "+v"(p1));
    float mx;
    { float a = max3f(p0[0], p0[1], p1[0]), c = max3f(p0[2], p0[3], p1[1]); a = max3f(a, p1[2], p1[3]);
#pragma unroll
      for (int i = 4; i < 16; i += 4) { a = max3f(a, p0[i], p0[i + 1]); c = max3f(c, p0[i + 2], p0[i + 3]); a = max3f(a, p1[i], p1[i + 1]); c = max3f(c, p1[i + 2], p1[i + 3]); }
      mx = max2f(a, c);
      const auto rr = __builtin_amdgcn_permlane32_swap(__float_as_uint(mx), __float_as_uint(mx), false, false);
      mx = max2f(__uint_as_float(rr[0]), __uint_as_float(rr[1])); }
    if (first || __any(mx > 8.0f)) {
        const float dl = first ? mx : fmaxf(mx, 0.f), alpha = __builtin_amdgcn_exp2f(-dl);
        mref += dl;
#pragma unroll
        for (int i = 0; i < 16; ++i) { p0[i] -= dl; p1[i] -= dl; negm[i] = -mref; }
        if (h == 0) wsf[r] = alpha;
        asm volatile("s_waitcnt lgkmcnt(0)" ::: "memory");
#pragma unroll
        for (int i = 0; i < 16; ++i) { const float a = wsf[crow(i, h)];
#pragma unroll
            for (int d = 0; d < 4; ++d) o[d][i] *= a; }
        lsum *= alpha;
    }
    float ps0 = 0.f, ps1 = 0.f;
#pragma unroll
    for (int i = 0; i < 16; ++i) { p0[i] = __builtin_amdgcn_exp2f(p0[i]); p1[i] = __builtin_amdgcn_exp2f(p1[i]); ps0 += p0[i]; ps1 += p1[i]; }
    lsum += ps0 + ps1;
    u32x4 w;
    w.x = pk2(p0[0], p0[1]); w.y = pk2(p0[2], p0[3]); w.z = pk2(p0[4], p0[5]); w.w = pk2(p0[6], p0[7]); pa[0] = __builtin_bit_cast(bf16x8, w);
    w.x = pk2(p0[8], p0[9]); w.y = pk2(p0[10], p0[11]); w.z = pk2(p0[12], p0[13]); w.w = pk2(p0[14], p0[15]); pa[1] = __builtin_bit_cast(bf16x8, w);
    w.x = pk2(p1[0], p1[1]); w.y = pk2(p1[2], p1[3]); w.z = pk2(p1[4], p1[5]); w.w = pk2(p1[6], p1[7]); pa[2] = __builtin_bit_cast(bf16x8, w);
    w.x = pk2(p1[8], p1[9]); w.y = pk2(p1[10], p1[11]); w.z = pk2(p1[12], p1[13]); w.w = pk2(p1[14], p1[15]); pa[3] = __builtin_bit_cast(bf16x8, w);
}
__device__ __forceinline__ void pv_step(const LAS unsigned char* vb, const bf16x8 (&pa)[4], f32x16 (&o)[4]) {
    s16x4 vlo[4][4], vhi[4][4];
#pragma unroll
    for (int db = 0; db < 4; ++db)
#pragma unroll
        for (int s = 0; s < 4; ++s) { vlo[db][s] = vtr(vb + (db * 4 + s) * 1024); vhi[db][s] = vtr(vb + (db * 4 + s) * 1024 + 512); }
    __builtin_amdgcn_sched_barrier(0);
    __builtin_amdgcn_s_setprio(1);
#pragma unroll
    for (int db = 0; db < 4; ++db)
#pragma unroll
        for (int s = 0; s < 4; ++s) { const bf16x8 vf = __builtin_shufflevector(vlo[db][s], vhi[db][s], 0, 1, 2, 3, 4, 5, 6, 7);
            o[db] = MFMA32(pa[s], vf, o[db]); }
    __builtin_amdgcn_s_setprio(0);
}

template <int MODE  > __device__ __forceinline__ void attn_unit(LAS unsigned char* lds, const bf16* proj, const bf16* qkn, bf16* mix, int b, int hd, int qb, const float* subg  , float lam, float oscale, int tid) {
    const int lane = tid & 63, r = lane & 31, h = lane >> 5; const int wid = __builtin_amdgcn_readfirstlane(tid >> 6);
    const int sub = wid >> 2, wq = wid & 3;
    const size_t rowbase = (size_t)b * SEQ; const int q0 = qb * 128, qw = q0 + wq * 32;
    const int NT = 2 * qb + 2, ntw = (qw >> 6) + 1;
    LAS float* wsf = (LAS float*)(lds + OFF_WS) + wid * 64;
    const unsigned dkoff = (unsigned)lane * 4096u, dvoff = (unsigned)(lane >> 2) * 4096u + (unsigned)(lane & 3) * 16u;
#pragma unroll
    for (int j = 0; j < NSTAGE; ++j) if (j < NT) dma_tile(lds + j * STAGE, proj, qkn, rowbase, hd, j, wid, dkoff, dvoff);
    bf16x8 qr[4];
    { const bf16* qp = qkn + (rowbase + (size_t)(qw + r)) * 2048 + hd * 128 + sub * 64 + 8 * h;
#pragma unroll
      for (int d0 = 0; d0 < 4; ++d0) qr[d0] = *(const bf16x8*)(qp + 16 * d0); }
    f32x16 o[4], negm;
#pragma unroll
    for (int i = 0; i < 16; ++i) { o[0][i] = 0.f; o[1][i] = 0.f; o[2][i] = 0.f; o[3][i] = 0.f; negm[i] = 0.f; }
    float mref = 0.f, lsum = 0.f;
    bf16x8 pa[4];
#pragma unroll
    for (int s = 0; s < 4; ++s) pa[s] = (bf16x8){0, 0, 0, 0, 0, 0, 0, 0};
    const int vlane = (4 * h + ((lane & 15) >> 2)) * 64 + ((lane >> 4) & 1) * 32 + (lane & 3) * 8;
    const LAS unsigned char* kbase = lds + sub * 8192 + h * 1024 + r * 16;
    const LAS unsigned char* vbase = lds + OFF_V + vlane;
    asm volatile("s_waitcnt vmcnt(0)" ::: "memory");
    asm volatile("" : "+v"(qr[0]), "+v"(qr[1]), "+v"(qr[2]), "+v"(qr[3]));
    __builtin_amdgcn_s_barrier();
#define STEP_BEGIN(t_) do { const int k_ = (t_) + 2; if ((t_) >= 2 && k_ < NT) dma_tile(lds + (k_ & 3) * STAGE, proj, qkn, rowbase, hd, k_, wid, dkoff, dvoff); } while (0)
#define STEP_END(t_) do { if ((t_) >= 2 && (t_) + 2 < NT) asm volatile("s_waitcnt vmcnt(4)" ::: "memory"); else asm volatile("s_waitcnt vmcnt(0)" ::: "memory"); \
        asm volatile("s_waitcnt lgkmcnt(0)" ::: "memory"); __builtin_amdgcn_s_barrier(); } while (0)
#define KB(t_) (kbase + ((t_) & 3) * STAGE)
#define VB(t_) (vbase + ((t_) & 3) * STAGE)
    if (sub == 0) {
        int t = 0;
        for (; t < ntw - 1; ++t) { STEP_BEGIN(t); s_step<false>(KB(t), qr, negm, mref, o, lsum, pa, wsf, r, h, 0, t == 0); pv_step(VB(t), pa, o); STEP_END(t); }
        { STEP_BEGIN(t); s_step<true>(KB(t), qr, negm, mref, o, lsum, pa, wsf, r, h, qw + r - 64 * t, t == 0); pv_step(VB(t), pa, o); STEP_END(t); ++t; }
        for (; t < NT; ++t) { STEP_BEGIN(t); STEP_END(t); }
        asm volatile("s_waitcnt lgkmcnt(0)" ::: "memory"); __builtin_amdgcn_s_barrier();
    } else {
        int t = 0;
        { STEP_BEGIN(0); if (ntw > 1) s_step<false>(KB(0), qr, negm, mref, o, lsum, pa, wsf, r, h, 0, true); else s_step<true>(KB(0), qr, negm, mref, o, lsum, pa, wsf, r, h, qw + r, true); STEP_END(0); t = 1; }
        for (; t < ntw - 1; ++t) { STEP_BEGIN(t); pv_step(VB(t - 1), pa, o); s_step<false>(KB(t), qr, negm, mref, o, lsum, pa, wsf, r, h, 0, false); STEP_END(t); }
        if (t < ntw) { STEP_BEGIN(t); pv_step(VB(t - 1), pa, o); s_step<true>(KB(t), qr, negm, mref, o, lsum, pa, wsf, r, h, qw + r - 64 * t, false); STEP_END(t); ++t; }
        if (t < NT) { STEP_BEGIN(t); pv_step(VB(t - 1), pa, o); STEP_END(t); ++t; for (; t < NT; ++t) { STEP_BEGIN(t); STEP_END(t); } }
        else pv_step(VB(t - 1), pa, o);
        asm volatile("s_waitcnt lgkmcnt(0)" ::: "memory"); __builtin_amdgcn_s_barrier();
    }
#undef STEP_BEGIN
#undef STEP_END
#undef KB
#undef VB
    int lane_f = lane; asm volatile("" : "+v"(lane_f));
    const int r_f = lane_f & 31, h_f = lane_f >> 5;
    { const auto rr = __builtin_amdgcn_permlane32_swap(__float_as_uint(lsum), __float_as_uint(lsum), false, false); lsum = __uint_as_float(rr[0]) + __uint_as_float(rr[1]); }
    if (h_f == 0) wsf[r_f] = (sub ? lam : 1.0f) / lsum;
    asm volatile("s_waitcnt lgkmcnt(0)" ::: "memory");
#pragma unroll
    for (int i = 0; i < 16; ++i) { const float a = wsf[crow(i, h_f)];
#pragma unroll
        for (int d = 0; d < 4; ++d) o[d][i] *= a; }
    LAS float* xo = (LAS float*)(lds + wq * 16384);
    if (sub == 1) {
#pragma unroll
        for (int d = 0; d < 4; ++d)
#pragma unroll
            for (int i = 0; i < 16; ++i) xo[crow(i, h_f) * 128 + 32 * d + r_f] = o[d][i];
    }
    __syncthreads();
    if (sub == 0) {
#pragma unroll
        for (int d = 0; d < 4; ++d)
#pragma unroll
            for (int i = 0; i < 16; ++i) { const int a = crow(i, h_f) * 128 + 32 * d + r_f; xo[a] = o[d][i] - xo[a]; }
    }
    __syncthreads();
    if (sub == 0) {
        const int row = lane_f >> 1, half = lane_f & 1;
        const LAS f32x4* src = (const LAS f32x4*)(xo + row * 128 + half * 64);
        f32x4 v[16]; float ss = 0.f;
#pragma unroll
        for (int j = 0; j < 16; ++j) { v[j] = src[j]; ss += (v[j].x * v[j].x + v[j].y * v[j].y) + (v[j].z * v[j].z + v[j].w * v[j].w); }
        ss += __shfl_xor(ss, 1);
        const float rstd = (1.0f / sqrtf(ss * (1.0f / 128.0f) + EPS)) * oscale;
        bf16* dst = mix + (rowbase + (size_t)(qw + row)) * DM + hd * 128 + half * 64;
        const f32x4* gs = (const f32x4*)(subg + half * 64);
#pragma unroll
        for (int j = 0; j < 8; ++j) { const f32x4 a = v[2 * j] * rstd * gs[2 * j], c = v[2 * j + 1] * rstd * gs[2 * j + 1];
            u32x4 w; w.x = pk2(a.x, a.y); w.y = pk2(a.z, a.w); w.z = pk2(c.x, c.y); w.w = pk2(c.z, c.w); *(u32x4*)(dst + 8 * j) = w; }
    }
    __syncthreads();
}
}

typedef unsigned v4u __attribute__((ext_vector_type(4)));
#define XB_TMO      128
#define XB_XCNT(j)  (256  + 64 * (j))
#define XB_XSUB(j)  (1280 + 64 * (j))
#define XB_XGEN(j)  (2304 + 64 * (j))
#define XB_TOP      3328
#define XB_TOPGEN   3392
#define XCD_BAR_WORDS 3456
#define XB_SPIN_CAP (1u << 18)

__device__ __forceinline__ unsigned xb_ld(unsigned* p)              { return __hip_atomic_load(p, __ATOMIC_RELAXED, __HIP_MEMORY_SCOPE_AGENT); }
__device__ __forceinline__ unsigned xb_add(unsigned* p, unsigned v) { return __hip_atomic_fetch_add(p, v, __ATOMIC_RELAXED, __HIP_MEMORY_SCOPE_AGENT); }
__device__ __forceinline__ unsigned xb_xcc_id() { return (unsigned)__builtin_amdgcn_s_getreg((3 << 11) | 20) & 0xFu; }
#define XB_SPIN(cond, bar) do { unsigned _sp = 0; while (cond) { __builtin_amdgcn_s_sleep(1); \
    if ((++_sp & 255u) == 0u) { if (xb_ld(&(bar)[XB_TMO])) break; if (_sp > XB_SPIN_CAP) { atomicAdd(&(bar)[XB_TMO], 1u); break; } } } } while (0)

struct XcdBarrier {
    unsigned* bar; unsigned x;
    volatile LAS unsigned* st;
};

__device__ __forceinline__ XcdBarrier xcd_barrier_post(unsigned* bar, volatile LAS unsigned* st) {
    XcdBarrier b; b.bar = bar; b.x = xb_xcc_id(); b.st = st;
    if (threadIdx.x == 0) (void)xb_add(&bar[XB_XCNT(b.x)], 1u);
    return b;
}
__device__ __forceinline__ void xcd_barrier_complete(unsigned* bar, unsigned x, unsigned& nloc, unsigned& nx) {
    const unsigned G = gridDim.x * gridDim.y * gridDim.z;
    unsigned sum, cnt, mine, sp = 0u;
    for (;;) {
        sum = 0u; cnt = 0u; mine = 0u;
#pragma unroll
        for (unsigned j = 0; j < 16; ++j) { const unsigned c = xb_ld(&bar[XB_XCNT(j)]); sum += c; cnt += (c > 0u) ? 1u : 0u; mine = (j == x) ? c : mine; }
        if (sum == G) break;
        __builtin_amdgcn_s_sleep(1);
        if ((++sp & 255u) == 0u) { if (xb_ld(&bar[XB_TMO])) break; if (sp > XB_SPIN_CAP) { atomicAdd(&bar[XB_TMO], 1u); break; } }
    }
    nloc = mine > 0u ? mine : 1u; nx = cnt > 0u ? cnt : 1u;
}

__device__ __forceinline__ void xcd_barrier(const XcdBarrier& b, const bool lead  ) {
    asm volatile("s_waitcnt vmcnt(0)" ::: "memory");
    __syncthreads();
    if (lead) {
        unsigned* bar = b.bar;
        __builtin_amdgcn_s_waitcnt(0);
        unsigned nloc = b.st[0], nx = b.st[1];
        if (nloc == 0u) { xcd_barrier_complete(bar, b.x, nloc, nx); b.st[0] = nloc; b.st[1] = nx; }
        const unsigned old = xb_add(&bar[XB_XSUB(b.x)], 1u);
        const unsigned gen = old / nloc;
        if (old + 1u == (gen + 1u) * nloc) {
            __builtin_amdgcn_fence(__ATOMIC_RELEASE, "agent");
            asm volatile("s_waitcnt vmcnt(0)" ::: "memory");
            const unsigned og = xb_add(&bar[XB_TOP], 1u);
            const unsigned tg = og / nx;
            if (og + 1u == (tg + 1u) * nx) xb_add(&bar[XB_TOPGEN], 1u);
            else XB_SPIN(xb_ld(&bar[XB_TOPGEN]) == tg, bar);
            __builtin_amdgcn_fence(__ATOMIC_ACQUIRE, "agent");
            xb_add(&bar[XB_XGEN(b.x)], 1u);
            asm volatile("s_waitcnt vmcnt(0)" ::: "memory");
        } else {
            XB_SPIN(xb_ld(&bar[XB_XGEN(b.x)]) == gen, bar);
            __builtin_amdgcn_fence(__ATOMIC_ACQUIRE, "agent");
            asm volatile("s_waitcnt vmcnt(0)" ::: "memory");
        }
    }
    __syncthreads();
}

#define XL_RANK(j) (3520 + 64 * (j))
#define XL_SUB(j)  (4608 + 64 * (j))
#define XL_GEN(j)  (5696 + 64 * (j))
constexpr int CTL_ZERO_BYTES = 32768;
__device__ __forceinline__ void xcd_local_barrier(unsigned* bar, unsigned x, unsigned nloc, const bool lead, volatile LAS unsigned* genw  ) {
    asm volatile("s_waitcnt vmcnt(0)" ::: "memory");
    __syncthreads();
    if (lead) {
        __builtin_amdgcn_s_waitcnt(0);
        const unsigned gen = genw[0]; genw[0] = gen + 1u;
        const unsigned old = xb_add(&bar[XL_SUB(x)], 1u);
        if (old + 1u == (gen + 1u) * nloc) xb_add(&bar[XL_GEN(x)], 1u);
        else XB_SPIN(xb_ld(&bar[XL_GEN(x)]) == gen, bar);
        __builtin_amdgcn_fence(__ATOMIC_ACQUIRE, "agent");
        asm volatile("s_waitcnt vmcnt(0)" ::: "memory");
    }
    __syncthreads();
}

__global__ void __launch_bounds__(NTHR, 2) fwd_kernel(Args A_by_value) {
    KArgs Ap0 = (KArgs)__builtin_amdgcn_kernarg_segment_ptr();
#define A (*Ap)
    KArgs Ap = Ap0;
    extern __shared__ __attribute__((aligned(16))) unsigned char lds_raw[];
    LAS unsigned char* lds = (LAS unsigned char*)lds_raw;
    cg::grid_group grid = cg::this_grid();
    const int wave0 = __builtin_amdgcn_readfirstlane((int)threadIdx.x >> 6);
    volatile LAS unsigned* MISC = (volatile LAS unsigned*)(lds + 131072);
    if (threadIdx.x < 64) MISC[threadIdx.x] = 0u;
    __syncthreads();
    const XcdBarrier bar = xcd_barrier_post((unsigned*)A.ws, MISC + 8);
    if (threadIdx.x == 0) { MISC[16] = xb_add(&((unsigned*)A.ws)[XL_RANK(bar.x)], 1u); MISC[17] = 0u; MISC[18] = 0u; }
    __syncthreads();
    int ph = A.ph_lo, rep = 0;
    while (ph < A.ph_hi) {
#if PROBE
        int ptype; if (ph == 0) ptype = 0; else if (ph == 1) ptype = 1; else { const int s_ = (ph - 2) % 7, l_ = (ph - 2) / 7; ptype = (s_ == 0 || s_ == 5) ? 2 : (s_ == 2 ? 3 : ((s_ == 1 || s_ == 6) ? 4 : (s_ == 4 ? 5 : ((l_ & 1) ? 7 : 9)))); }
        const int nrep = 1 + ((PROBE >> ptype) & 1);
#else
        const int nrep = 1;
#endif
        Ap = Ap0; asm volatile("" : "+s"(Ap));
#define tid fresh_tid(wave0)
#define lane (fresh_tid(wave0) & 63)
#define wave wave0
        const int G = gridDim.x;
        if (ph >= 2 && (unsigned)__builtin_amdgcn_readfirstlane((int)MISC[17]) == 0u) {
            if (fresh_tid(wave0) == 0) { unsigned ok = (G % 8 == 0) ? 1u : 0u;
                for (unsigned j = 0; j < 16; ++j) { const unsigned c = xb_ld(&((unsigned*)A.ws)[XL_RANK(j)]); if (c != (j < 8 ? (unsigned)G >> 3 : 0u)) ok = 0u; }
                MISC[17] = ok ? 1u : 2u; }
            __syncthreads();
        }
        const bool teamed = (ph >= 2) && (unsigned)__builtin_amdgcn_readfirstlane((int)MISC[17]) == 1u;
        const int vc = teamed ? (int)((unsigned)__builtin_amdgcn_readfirstlane((int)MISC[16]) * 8u + bar.x) : (int)blockIdx.x;
        unsigned char* ws = A.ws; asm volatile("" : "+s"(ws));
        float* const mod = (float*)(ws + WS_MOD);
        bf16* const Hb = (bf16*)(ws + WS_H); bf16* const MIXb = (bf16*)(ws + WS_MIX); bf16* const ACTb = (bf16*)(ws + WS_ACT);
        float* const rowss = (float*)(ws + WS_ROWSS);
        if (ph == 0) { prep_phase(Ap, lds, tid, lane, wave); }
        else if (ph == 1) { prep2_phase(Ap, lane, wave); }
        else {
            const int l = (ph - 2) / 7, s = (ph - 2) % 7, e = l >> 1;
            const float* modl = mod + (size_t)l * 2 * NMOD;
            const float* xcur = (ph <= 3) ? A.in[0] : A.out;
            const float* biasl = (const float*)(ws + WS_BIAS) + (size_t)l * BIAS_L;
            if (s == 0 || s == 5 || s == 2) {
                const bf16* W; int N, ldc, pn0, colbase, act, qkn = 0; const float* bias;
                if (s != 2) { W = (const bf16*)(ws + WS_WGU) + (size_t)(l * 2 + (s == 0 ? 0 : 1)) * 5632 * 1024; N = 5632; ldc = FF; pn0 = 0; colbase = 0; act = 1; bias = biasl + (s == 0 ? 0 : BIAS_F2); }
                else if ((l & 1) == 0) { W = (const bf16*)(ws + WS_WINAB) + (size_t)e * 2048 * 1024; N = 2048; ldc = 2048; pn0 = 8; colbase = 0; act = 0; bias = biasl + BIAS_MIX; qkn = 1; }
                else { W = (const bf16*)(ws + WS_WINC) + (size_t)e * 3072 * 1024; N = 3072; ldc = 2048; pn0 = 4; colbase = 1024; act = 0; bias = biasl + BIAS_MIX; }
                pg8::Gemm g{Hb, W, M, N, DM, (PROBE_BLIN && rep + 1 < nrep) ? 1 : 0}; pg8::StaticOrder S; S.init(M, N, G, vc);
                LAS unsigned* EP = (LAS unsigned*)(lds + 131072 + 256);
                if (tid == 0) pg8::EpiMix::put(EP, ACTb, ldc, pn0, colbase, act, rowss, bias, N, qkn, A.in[9] + e * 128);
                __syncthreads();
                pg8::EpiMix E{EP};
                pg8::gemm_phase<pg8::EpiMix, pg8::StaticOrder, true, true>(lds, g, S, E, tid);
            } else if (s == 1 || s == 6 || s == 4) {
                const bf16* Ain; const bf16* W; int K; const float* gate; float gs;
                if (s != 4) { Ain = ACTb; W = (const bf16*)(ws + WS_WD) + (size_t)(l * 2 + (s == 1 ? 0 : 1)) * 1024 * FF; K = FF; gate = modl + (s == 1 ? 2 : 8) * DM; gs = 0.5f; }
                else { Ain = MIXb; W = ((l & 1) == 0 ? (const bf16*)(ws + WS_WOUTAB) : (const bf16*)(ws + WS_WOUTC)) + (size_t)e * DM * DM; K = DM; gate = modl + 5 * DM; gs = 1.0f; }
                const int nl = (s == 6) ? l + 1 : l, nj = (s == 1) ? 1 : (s == 4 ? 2 : 0);
                const int has_nxt = nl < 4, nlc = has_nxt ? nl : 3;
                const float* ng = A.in[2] + (size_t)(nlc * 3 + nj) * DM;
                const float* nsc = mod + (size_t)nlc * 2 * NMOD + (3 * nj + 1) * DM;
                pg8::Gemm g{Ain, W, M, DM, K, 0}; pg8::StaticOrder S; S.init(M, DM, G, vc);
                LAS unsigned* EP = (LAS unsigned*)(lds + 131072 + 256);
                if (tid == 0) pg8::EpiRes::put(EP, xcur, A.out, gate, (rep + 1 < nrep) ? 0.0f : gs, ng, nsc, Hb, rowss, has_nxt);
                __syncthreads();
                pg8::EpiRes E{EP};
                pg8::gemm_phase<pg8::EpiRes, pg8::StaticOrder, true, true>(lds, g, S, E, tid);
            } else {
                if ((l & 1) == 0) {
                    for (int rp = 0; rp < 1 + ((PROBE >> 6) & 1); ++rp) pool_phase(ACTb, MIXb, lane, wave);
                    const float* lq1 = A.in[10] + e * 64; const float* lk1 = A.in[11] + e * 64; const float* lq2 = A.in[12] + e * 64; const float* lk2 = A.in[13] + e * 64;
                    float s1 = 0.f, s2 = 0.f;
                    for (int i = 0; i < 64; ++i) { s1 += lq1[i] * lk1[i]; s2 += lq2[i] * lk2[i]; }
                    const float lam_init = 0.8f - 0.6f * expf(-0.3f * (float)l);
                    const float lam = expf(s1) - expf(s2) + lam_init;
                    for (int ui = 0; ui < 2; ++ui) {
                        for (int v0 = vc; v0 < 256; v0 += G) {
                            const int v = (G == 256) ? (v0 & 7) * 32 + (v0 >> 3) : v0;
                            const int bh = v >> 5, x = v & 31, qb = ui == 0 ? 63 - x : x;
#if PROBE_ATT
                            att::attn_unit<PROBE_ATT>(lds, ACTb, ACTb, MIXb, bh >> 2, bh & 3, qb, A.in[14] + e * 128, lam, 1.0f - lam_init, tid);
#endif
                            att::attn_unit<0>(lds, ACTb, ACTb, MIXb, bh >> 2, bh & 3, qb, A.in[14] + e * 128, lam, 1.0f - lam_init, tid);
                        }
                    }
                } else conv_phase(ACTb, MIXb, A.in[19] + (size_t)e * 3 * DM, tid);
            }
        }
        if (ph + 1 < A.ph_hi || rep + 1 < nrep) {
            const int s_ = (ph >= 2) ? (ph - 2) % 7 : -1;
            if (A.ph_hi > 1000000) grid.sync();
            else if (teamed && !PROBE && (s_ == 0 || s_ == 1 || s_ == 4 || s_ == 5 || s_ == 6)) xcd_local_barrier(bar.bar, bar.x, (unsigned)G >> 3, fresh_tid(wave0) == 0, MISC + 18);
            else xcd_barrier(bar, fresh_tid(wave0) == 0);
        }
        if (rep + 1 < nrep) ++rep; else { rep = 0; ++ph; }
    }
}

#ifndef PROBE
#define PROBE 0
#endif
#undef tid
#undef lane
#undef wave
#undef A
#ifndef N_LAUNCH_MODE
#define N_LAUNCH_MODE 1
#endif
extern "C" void kernel_launch(void* const* d_in, const int* in_sizes, int n_in, void* d_out, int out_size, void* d_ws, size_t ws_size, hipStream_t stream) {
    static int grid = 0;
    if (grid == 0) {
        if (n_in != 21 || out_size != M * DM || ws_size < WS_END) { fprintf(stderr, "kernel_launch: unexpected problem (n_in %d out %d ws %zu)\n", n_in, out_size, ws_size); grid = -1; return; }
        int dev = 0, cus = 0, per_cu = 0;
        hipGetDevice(&dev); hipDeviceGetAttribute(&cus, hipDeviceAttributeMultiprocessorCount, dev);
        if (hipFuncSetAttribute((const void*)fwd_kernel, hipFuncAttributeMaxDynamicSharedMemorySize, LDS_BYTES) != hipSuccess) { fprintf(stderr, "kernel_launch: hipFuncSetAttribute failed\n"); grid = -1; return; }
        if (hipOccupancyMaxActiveBlocksPerMultiprocessor(&per_cu, (const void*)fwd_kernel, NTHR, LDS_BYTES) != hipSuccess || per_cu < 1) { fprintf(stderr, "kernel_launch: occupancy query says %d\n", per_cu); per_cu = 1; }
        (void)hipGetLastError();
        grid = cus * 1;
    }
    if (grid < 0) return;
    if (hipMemsetAsync(d_ws, 0, CTL_ZERO_BYTES, stream) != hipSuccess) { fprintf(stderr, "kernel_launch: memset of the barrier words failed\n"); return; }
    Args a{};
    for (int i = 0; i < 21; ++i) a.in[i] = (const float*)d_in[i];
    a.out = (float*)d_out; a.ws = (unsigned char*)d_ws;
    constexpr int NPH = 30;
#if N_LAUNCH_MODE == 0
    for (int ph = 0; ph < NPH; ++ph) { a.ph_lo = ph; a.ph_hi = ph + 1; hipLaunchKernelGGL(fwd_kernel, dim3(grid), dim3(NTHR), LDS_BYTES, stream, a); }
#else
    a.ph_lo = 0; a.ph_hi = NPH;
    void* args[] = {&a};
    hipError_t e = hipLaunchCooperativeKernel((const void*)fwd_kernel, dim3(grid), dim3(NTHR), args, LDS_BYTES, stream);
    if (e != hipSuccess) fprintf(stderr, "cooperative launch failed: %s (grid %d)\n", hipGetErrorString(e), grid);
#endif
}
```

```cpp
#include <hip/hip_runtime.h>
#include <hip/hip_cooperative_groups.h>
#include <cstdio>
#include <cstdint>
namespace cg = cooperative_groups;
namespace pg8 {
#define PG8_LAS __attribute__((address_space(3)))
typedef unsigned short bf16_t;
typedef short bf16x8 __attribute__((ext_vector_type(8)));
typedef float f32x4 __attribute__((ext_vector_type(4)));
typedef unsigned u32x4 __attribute__((ext_vector_type(4)));
constexpr int BM = 256, BK = 64, HALF = 128, HTB = HALF * BK * 2  , STAGE_BYTES = 8 * HTB, NXCD = 8, WGM = 8;

__host__ __device__ __forceinline__ int lds_byte(int r, int c) { const int st = (r >> 4) * 2 + (c >> 5), rr = r & 15, cc = c & 31, ob = rr * 64 + cc * 2; return st * 1024 + (ob ^ (((ob >> 9) & 1) << 5)); }
__host__ __device__ __forceinline__ void stage_rc(int b, int& R, int& C) { const int st = b / 1024, sb = b % 1024, swz = sb ^ (((sb >> 9) & 1) << 5); R = (st >> 1) * 16 + swz / 64; C = (st & 1) * 32 + (swz % 64) / 2; }
__host__ __device__ __forceinline__ int perm32(int rho) { const int n = rho >> 4, i = rho & 15; return 8 * (i >> 2) + 4 * n + (i & 3); }

struct Unit { int pm, pn, half, narrow; };
struct Gemm { const bf16_t* A; const bf16_t* Bt; int M, N, K; int blin; };

struct StaticOrder {
    int nM, nN, nwg, G, c, nfull, tail;
    __host__ __device__ void init(int M, int N, int G_, int c_) { nM = M / BM; nN = N / BM; nwg = nM * nN; G = G_; c = c_; nfull = nwg / G; tail = ((nwg % G) * 2 == G && (G % 16) == 0) ? 1 : 0; }
    __host__ __device__ bool next(int i, Unit& u) const {
        long L = (long)i * G + c; u.half = 0; u.narrow = 0;
        if (tail && i >= nfull) { if (i > nfull) return false; const int x = c % NXCD, li = c / NXCD; L = (long)nfull * G + (li >> 1) * NXCD + x; u.half = li & 1; u.narrow = 1; }
        if (L >= nwg) return false;
        int wgid = (int)L; { const int q = nwg / NXCD, r = nwg % NXCD, xcd = wgid % NXCD, off = wgid / NXCD; wgid = (xcd < r ? xcd * (q + 1) : r * (q + 1) + (xcd - r) * q) + off; }
        const int nig = WGM * nN, gid = wgid / nig, fm = gid * WGM, gsz = (nM - fm) < WGM ? (nM - fm) : WGM;
        u.pm = fm + ((wgid % nig) % gsz); u.pn = (wgid % nig) / gsz; return true;
    }
    __device__ __forceinline__ void a_ready(const Unit&) const {}
    __device__ __forceinline__ void done(const Unit&) const {}
};

typedef float f32x2 __attribute__((ext_vector_type(2)));
typedef __bf16 bf16x2_t __attribute__((ext_vector_type(2)));
__device__ __forceinline__ unsigned cvt_pk_bf16(float lo, float hi) { f32x2 v = {lo, hi}; bf16x2_t b = __builtin_convertvector(v, bf16x2_t); return __builtin_bit_cast(unsigned, b); }
__device__ __forceinline__ float silu_f(float v) { return v * __builtin_amdgcn_rcpf(1.0f + __builtin_amdgcn_exp2f(-1.4426950408889634f * v)); }

#define PG8_GAS __attribute__((address_space(1)))
template <class T> __device__ __forceinline__ T* lds_ptr(const PG8_LAS unsigned* q) { const unsigned lo = __builtin_amdgcn_readfirstlane(q[0]), hi = __builtin_amdgcn_readfirstlane(q[1]); return (T*)(((unsigned long long)hi << 32) | lo); }
__device__ __forceinline__ int lds_int(const PG8_LAS unsigned* q) { return (int)__builtin_amdgcn_readfirstlane(q[0]); }
__device__ __forceinline__ void lds_put(PG8_LAS unsigned* q, const void* p) { const unsigned long long v = (unsigned long long)p; q[0] = (unsigned)v; q[1] = (unsigned)(v >> 32); }
struct EpiMix {
    static constexpr bool PERM = true, AFTER_DRAIN = false;
    const PG8_LAS unsigned* P;
    static __device__ __forceinline__ void put(PG8_LAS unsigned* P, bf16_t* O, int ldc, int pn0, int colbase, int act, const float* rowss, const float* bias, int N, int qkn, const float* qkg) {
        lds_put(P, O); lds_put(P + 2, rowss); lds_put(P + 4, bias); P[6] = ldc; P[7] = pn0; P[8] = colbase; P[9] = act; P[10] = N; P[11] = qkn; lds_put(P + 12, qkg); P[14] = 0xFFFFFFFFu; }
    __device__ __forceinline__ void operator()(const f32x4 (&acc)[2][2][4][2], const Unit& u, int wr, int wc, int fr, int fq) const {
        PG8_GAS bf16_t* const O = (PG8_GAS bf16_t*)lds_ptr<bf16_t>(P); const PG8_GAS float* const rowss = (const PG8_GAS float*)lds_ptr<const float>(P + 2); const PG8_GAS float* const bias = (const PG8_GAS float*)lds_ptr<const float>(P + 4);
        const int ldc = lds_int(P + 6), pn0 = lds_int(P + 7), colbase = lds_int(P + 8), act_silu = lds_int(P + 9), N = lds_int(P + 10);
        const int row0 = u.pm * BM + u.half * HALF + wr * 64 + fr; const int nai = u.narrow ? 1 : 2;
        PG8_LAS float* RS = (PG8_LAS float*)((PG8_LAS unsigned char*)P - 256 + 12288);
        if (lds_int(P + 14) != u.pm) {
            const int t = (wr * 4 + wc) * 64 + fq * 16 + fr;
            if (t < 256) { const PG8_GAS f32x4* sp = (const PG8_GAS f32x4*)(rowss + (size_t)(u.pm * BM + t) * 16);
                const f32x4 a = sp[0], b = sp[1], c = sp[2], d = sp[3];
                const float ss = ((a[0] + a[1]) + (a[2] + a[3])) + ((b[0] + b[1]) + (b[2] + b[3])) + ((c[0] + c[1]) + (c[2] + c[3])) + ((d[0] + d[1]) + (d[2] + d[3]));
                RS[t] = 1.0f / sqrtf(ss * (1.0f / 1024.0f) + 1e-6f); }
            asm volatile("s_waitcnt lgkmcnt(0)" ::: "memory"); __builtin_amdgcn_s_barrier(); asm volatile("" ::: "memory");
            if (t == 0) ((PG8_LAS unsigned*)P)[14] = (unsigned)u.pm;
        }
        float rs[2][4];
#pragma unroll
        for (int ai = 0; ai < 2; ++ai)
#pragma unroll
            for (int m = 0; m < 4; ++m) rs[ai][m] = RS[u.half * HALF + (ai < nai ? ai : 0) * HALF + wr * 64 + m * 16 + fr];
        const PG8_GAS float* bp = bias + (size_t)((u.pm * BM) / 8192) * N + u.pn * BM + wc * 32 + 8 * fq;
        f32x4 bv[2][2];
#pragma unroll
        for (int bj = 0; bj < 2; ++bj)
#pragma unroll
            for (int n = 0; n < 2; ++n) bv[bj][n] = *(const PG8_GAS f32x4*)(bp + bj * HALF + 4 * n);
        if (u.pn < pn0 && lds_int(P + 11) != 0 && u.pn < 4) {
            const PG8_GAS float* const qkg = (const PG8_GAS float*)lds_ptr<const float>(P + 12);
            PG8_LAS float* X = (PG8_LAS float*)((PG8_LAS unsigned char*)P - 256 + 4096);
            const int col0 = u.pn * BM + wc * 32 + 8 * fq;
#pragma unroll
            for (int ai = 0; ai < 2; ++ai)
#pragma unroll
                for (int m = 0; m < 4; ++m)
#pragma unroll
                    for (int bj = 0; bj < 2; ++bj) { const f32x4 v0 = acc[ai][bj][m][0] * rs[ai][m] + bv[bj][0], v1 = acc[ai][bj][m][1] * rs[ai][m] + bv[bj][1];
                        float ss = ((v0[0] * v0[0] + v0[1] * v0[1]) + (v0[2] * v0[2] + v0[3] * v0[3])) + ((v1[0] * v1[0] + v1[1] * v1[1]) + (v1[2] * v1[2] + v1[3] * v1[3]));
                        ss += __shfl_xor(ss, 16); ss += __shfl_xor(ss, 32);
                        if (fq == 0) X[((ai * HALF + wr * 64 + m * 16 + fr) * 2 + bj) * 4 + wc] = ss; }
            asm volatile("s_waitcnt lgkmcnt(0)" ::: "memory"); __builtin_amdgcn_s_barrier(); asm volatile("" ::: "memory");
            const float qs = (u.pn < 2) ? 0.125f * 1.4426950408889634f : 1.0f;
            const PG8_GAS float* gp = qkg + (u.pn < 2 ? 0 : 64) + (wc & 1) * 32 + 8 * fq;
            const f32x4 g0 = *(const PG8_GAS f32x4*)gp, g1 = *(const PG8_GAS f32x4*)(gp + 4);
#pragma unroll
            for (int ai = 0; ai < 2; ++ai)
#pragma unroll
                for (int m = 0; m < 4; ++m) { PG8_GAS bf16_t* rowp = O + (size_t)(row0 + ai * HALF + m * 16) * ldc + col0;
#pragma unroll
                    for (int bj = 0; bj < 2; ++bj) { const PG8_LAS float* xp = X + ((ai * HALF + wr * 64 + m * 16 + fr) * 2 + bj) * 4;
                        const float tot = xp[wc] + xp[wc ^ 1], rn = (1.0f / sqrtf(tot * (1.0f / 64.0f) + 1e-6f)) * qs;
                        const f32x4 v0 = (acc[ai][bj][m][0] * rs[ai][m] + bv[bj][0]) * rn * g0, v1 = (acc[ai][bj][m][1] * rs[ai][m] + bv[bj][1]) * rn * g1;
                        u32x4 w; w.x = cvt_pk_bf16(v0[0], v0[1]); w.y = cvt_pk_bf16(v0[2], v0[3]); w.z = cvt_pk_bf16(v1[0], v1[1]); w.w = cvt_pk_bf16(v1[2], v1[3]);
                        *(PG8_GAS u32x4*)(rowp + bj * HALF) = w; } }
        } else if (u.pn < pn0) {
            const int col0 = u.pn * BM + wc * 32 + 8 * fq;
#pragma unroll
            for (int ai = 0; ai < 2; ++ai) if (ai < nai)
#pragma unroll
                for (int m = 0; m < 4; ++m) { PG8_GAS bf16_t* rowp = O + (size_t)(row0 + ai * HALF + m * 16) * ldc + col0;
#pragma unroll
                    for (int bj = 0; bj < 2; ++bj) { const f32x4 v0 = acc[ai][bj][m][0] * rs[ai][m] + bv[bj][0], v1 = acc[ai][bj][m][1] * rs[ai][m] + bv[bj][1];
                        u32x4 w; w.x = cvt_pk_bf16(v0[0], v0[1]); w.y = cvt_pk_bf16(v0[2], v0[3]); w.z = cvt_pk_bf16(v1[0], v1[1]); w.w = cvt_pk_bf16(v1[2], v1[3]);
                        *(PG8_GAS u32x4*)(rowp + bj * HALF) = w; } }
        } else {
            const int col0 = colbase + (u.pn - pn0) * HALF + wc * 32 + 8 * fq;
#pragma unroll
            for (int ai = 0; ai < 2; ++ai) if (ai < nai)
#pragma unroll
                for (int m = 0; m < 4; ++m) { PG8_GAS bf16_t* rowp = O + (size_t)(row0 + ai * HALF + m * 16) * ldc + col0;
                    f32x4 g0 = acc[ai][0][m][0] * rs[ai][m] + bv[0][0], g1 = acc[ai][0][m][1] * rs[ai][m] + bv[0][1]; const f32x4 u0 = acc[ai][1][m][0] * rs[ai][m] + bv[1][0], u1 = acc[ai][1][m][1] * rs[ai][m] + bv[1][1];
                    if (act_silu) {
#pragma unroll
                        for (int e = 0; e < 4; ++e) { g0[e] = silu_f(g0[e]); g1[e] = silu_f(g1[e]); } }
                    g0 = g0 * u0; g1 = g1 * u1;
                    u32x4 w; w.x = cvt_pk_bf16(g0[0], g0[1]); w.y = cvt_pk_bf16(g0[2], g0[3]); w.z = cvt_pk_bf16(g1[0], g1[1]); w.w = cvt_pk_bf16(g1[2], g1[3]);
                    *(PG8_GAS u32x4*)rowp = w; }
        }
    }
};
struct EpiRes {
    static constexpr bool PERM = true, AFTER_DRAIN = false;
    const PG8_LAS unsigned* P;
    static constexpr int gstride = 9216, rows_per_batch = 8192;
    static __device__ __forceinline__ void put(PG8_LAS unsigned* P, const float* base, float* out, const float* gate, float gs, const float* nxt_g, const float* nxt_scale, bf16_t* xg, float* rowss, int has_nxt) {
        lds_put(P, base); lds_put(P + 2, out); lds_put(P + 4, gate); lds_put(P + 6, nxt_g); lds_put(P + 8, nxt_scale); lds_put(P + 10, xg); lds_put(P + 12, rowss); P[14] = __float_as_uint(gs); P[15] = has_nxt; }
    __device__ __forceinline__ void operator()(const f32x4 (&acc)[2][2][4][2], const Unit& u, int wr, int wc, int fr, int fq) const {
        const PG8_GAS float* const base = (const PG8_GAS float*)lds_ptr<const float>(P); PG8_GAS float* const out = (PG8_GAS float*)lds_ptr<float>(P + 2); const PG8_GAS float* const gate = (const PG8_GAS float*)lds_ptr<const float>(P + 4);
        const PG8_GAS float* const nxt_g = (const PG8_GAS float*)lds_ptr<const float>(P + 6); const PG8_GAS float* const nxt_scale = (const PG8_GAS float*)lds_ptr<const float>(P + 8);
        PG8_GAS bf16_t* const xg = (PG8_GAS bf16_t*)lds_ptr<bf16_t>(P + 10); PG8_GAS float* const rowss = (PG8_GAS float*)lds_ptr<float>(P + 12);
        const float gs = __uint_as_float((unsigned)lds_int(P + 14)); const int has_nxt = lds_int(P + 15);
        const int row0 = u.pm * BM + wr * 64 + fr, col0 = u.pn * BM + wc * 32 + 8 * fq;
        const int b = (u.pm * BM) / rows_per_batch;
        const PG8_GAS float* gp = gate + (size_t)b * gstride + col0;
        f32x4 bx[3][2][2];
#define PG8_LDROW(it_, buf_) do { const size_t off_ = (size_t)(row0 + ((it_) >> 2) * HALF + ((it_) & 3) * 16) * 1024 + col0; \
            _Pragma("unroll") for (int bj = 0; bj < 2; ++bj) { bx[buf_][bj][0] = *(const PG8_GAS f32x4*)(base + off_ + bj * HALF); bx[buf_][bj][1] = *(const PG8_GAS f32x4*)(base + off_ + bj * HALF + 4); } } while (0)
        PG8_LDROW(0, 0); PG8_LDROW(1, 1);
        f32x4 gv[2][2], gm[2][2];
#pragma unroll
        for (int bj = 0; bj < 2; ++bj)
#pragma unroll
            for (int n = 0; n < 2; ++n) { gv[bj][n] = *(const PG8_GAS f32x4*)(gp + bj * HALF + 4 * n) * gs;
                gm[bj][n] = *(const PG8_GAS f32x4*)(nxt_g + col0 + bj * HALF + 4 * n) * (*(const PG8_GAS f32x4*)(nxt_scale + (size_t)b * gstride + col0 + bj * HALF + 4 * n) + 1.0f); }
#pragma unroll
        for (int it = 0; it < 8; ++it) { const int ai = it >> 2, m = it & 3; const int row = row0 + ai * HALF + m * 16; const size_t off = (size_t)row * 1024 + col0; float ss = 0.f;
            if (it + 2 < 8) PG8_LDROW(it + 2, (it + 2) % 3);
#pragma unroll
            for (int bj = 0; bj < 2; ++bj) {
                const f32x4 x0 = bx[it % 3][bj][0] + gv[bj][0] * acc[ai][bj][m][0], x1 = bx[it % 3][bj][1] + gv[bj][1] * acc[ai][bj][m][1];
                *(PG8_GAS f32x4*)(out + off + bj * HALF) = x0; *(PG8_GAS f32x4*)(out + off + bj * HALF + 4) = x1;
                if (has_nxt) { ss += ((x0[0] * x0[0] + x0[1] * x0[1]) + (x0[2] * x0[2] + x0[3] * x0[3])) + ((x1[0] * x1[0] + x1[1] * x1[1]) + (x1[2] * x1[2] + x1[3] * x1[3]));
                    const f32x4 y0 = x0 * gm[bj][0], y1 = x1 * gm[bj][1];
                    u32x4 w; w.x = cvt_pk_bf16(y0[0], y0[1]); w.y = cvt_pk_bf16(y0[2], y0[3]); w.z = cvt_pk_bf16(y1[0], y1[1]); w.w = cvt_pk_bf16(y1[2], y1[3]);
                    *(PG8_GAS u32x4*)(xg + off + bj * HALF) = w; } }
            if (has_nxt) { ss += __shfl_xor(ss, 16); ss += __shfl_xor(ss, 32); if (fq == 0) rowss[(size_t)row * 16 + u.pn * 4 + wc] = ss; } }
#undef PG8_LDROW
    }
};

template <class Epi, class Sched, bool ALIGN_EPI = false, bool SP2 = false>
__device__ __forceinline__ void gemm_phase(PG8_LAS unsigned char* lds, const Gemm g, const Sched& S, const Epi& E, const int tid_in) {
    int tid_o = tid_in; asm volatile("" : "+v"(tid_o));
    const int tid = tid_o, wid = __builtin_amdgcn_readfirstlane(tid >> 6), lane = tid & 63, wr = wid >> 2, wc = wid & 3, fr = lane & 15, fq = lane >> 4;
    const int K = g.K, nt = K / BK;
    unsigned voffA[2], voffB[2];
#pragma unroll
    for (int i = 0; i < 2; ++i) { int R, C; stage_rc(tid * 16 + i * 8192, R, C); const int Rb = Epi::PERM ? ((R & ~31) + perm32(R & 31)) : R;
        voffA[i] = (unsigned)(R * K + C) * 2u; voffB[i] = (g.blin & 1) ? (unsigned)(tid * 16 + i * 8192) : (unsigned)(Rb * K + C) * 2u; }
    const size_t kstep = (size_t)(BK * 2);
    const size_t kstepB = (g.blin & 1) ? (size_t)16384 : kstep;
    const size_t hstep = (size_t)HALF * K * 2;
    const size_t tstep = 2 * hstep;
    const unsigned ldsbase = (unsigned)__builtin_amdgcn_readfirstlane((int)(unsigned)(uintptr_t)lds);
    const unsigned ldsw = (unsigned)wid * 1024u;
    const int aoff = lds_byte(wr * 64 + fr, fq * 8), boff = lds_byte(wc * 32 + fr, fq * 8);
#define PG8_SA(b, h) (((b) * 2 + (h)) * HTB)
#define PG8_SB(b, h) ((4 + (b) * 2 + (h)) * HTB)
#define PG8_STAGE(bufoff, gbase, voff) do { _Pragma("unroll") for (int _i = 0; _i < 2; ++_i) { unsigned keep_; \
        asm volatile("s_mov_b32 %0, m0\n\ts_mov_b32 m0, %3\n\ts_nop 0\n\tglobal_load_lds_dwordx4 %1, %2\n\ts_mov_b32 m0, %0" : "=&s"(keep_) \
            : "v"((voff)[_i]), "s"((const char*)(gbase)), "s"(ldsbase + (unsigned)(bufoff) + ldsw + (unsigned)(_i * 8192)) : "memory"); } } while (0)
#define PG8_LDA(dst, b, h) do { _Pragma("unroll") for (int m = 0; m < 4; ++m) _Pragma("unroll") for (int k = 0; k < 2; ++k) dst[m][k] = *(const PG8_LAS bf16x8*)(lds + PG8_SA(b, h) + aoff + m * 2048 + k * 1024); } while (0)
#define PG8_LDB(dst, b, h) do { _Pragma("unroll") for (int n = 0; n < 2; ++n) _Pragma("unroll") for (int k = 0; k < 2; ++k) dst[n][k] = *(const PG8_LAS bf16x8*)(lds + PG8_SB(b, h) + boff + n * 2048 + k * 1024); } while (0)
#define PG8_MMA(ai, bj, At, Bt) do { __builtin_amdgcn_s_setprio(1); _Pragma("unroll") for (int m = 0; m < 4; ++m) _Pragma("unroll") for (int n = 0; n < 2; ++n) _Pragma("unroll") for (int k = 0; k < 2; ++k) \
        acc[ai][bj][m][n] = __builtin_amdgcn_mfma_f32_16x16x32_bf16(Bt[n][k], At[m][k], acc[ai][bj][m][n], 0, 0, 0); __builtin_amdgcn_s_setprio(0); } while (0)
#define PG8_WAIT_V(n) asm volatile("s_waitcnt vmcnt(" #n ")" ::: "memory")
#define PG8_WAIT_L(n) asm volatile("s_waitcnt lgkmcnt(" #n ")" ::: "memory")
#define PG8_BAR __builtin_amdgcn_s_barrier()
#define PG8_SCHED __builtin_amdgcn_sched_barrier(0)
    Unit cur, nxt; int ui = 0;
    if (!S.next(0, cur)) return;
    f32x4 acc[2][2][4][2];
#pragma unroll
    for (int a = 0; a < 2; ++a)
#pragma unroll
        for (int b = 0; b < 2; ++b)
#pragma unroll
            for (int m = 0; m < 4; ++m)
#pragma unroll
                for (int n = 0; n < 2; ++n) acc[a][b][m][n] = (f32x4){0.f, 0.f, 0.f, 0.f};
    bf16x8 At[4][2], B0[2][2], B1[2][2];
    const char* cA = (const char*)g.A + (size_t)cur.pm * tstep + (size_t)cur.half * hstep; const char* cB = (const char*)g.Bt + (size_t)cur.pn * tstep;
    S.a_ready(cur);
    if constexpr (SP2) {
        PG8_STAGE(PG8_SB(0, 0), cB, voffB); PG8_STAGE(PG8_SB(0, 1), cB + hstep, voffB); PG8_STAGE(PG8_SA(0, 0), cA, voffA); PG8_STAGE(PG8_SA(0, 1), cA + hstep, voffA);
        if (wr == 1) PG8_BAR;
        PG8_WAIT_V(2); PG8_BAR;
        PG8_STAGE(PG8_SB(1, 0), cB + kstepB, voffB); PG8_STAGE(PG8_SA(1, 0), cA + kstep, voffA); PG8_STAGE(PG8_SB(1, 1), cB + hstep + kstepB, voffB);
        PG8_WAIT_V(6); PG8_BAR;
    } else {
        PG8_STAGE(PG8_SB(0, 0), cB, voffB); PG8_STAGE(PG8_SA(0, 0), cA, voffA); PG8_STAGE(PG8_SB(0, 1), cB + hstep, voffB); PG8_STAGE(PG8_SA(0, 1), cA + hstep, voffA);
        if (wr == 1) PG8_BAR;
        PG8_WAIT_V(4); PG8_BAR;
        PG8_STAGE(PG8_SB(1, 0), cB + kstepB, voffB); PG8_STAGE(PG8_SA(1, 0), cA + kstep, voffA); PG8_STAGE(PG8_SB(1, 1), cB + hstep + kstepB, voffB);
        PG8_WAIT_V(6); PG8_BAR;
    }
    for (;;) {
        const bool has_next = S.next(ui + 1, nxt);
        const char* nA = has_next ? (const char*)g.A + (size_t)nxt.pm * tstep + (size_t)nxt.half * hstep : cA; const char* nB = has_next ? (const char*)g.Bt + (size_t)nxt.pn * tstep : cB;
        const bool narrow_u = cur.narrow != 0;
        for (int t = 0; t < nt; t += 2) {
            const bool last = (t == nt - 2);
            const char* a1 = cA + (size_t)(t + 1) * kstep;
            const char* a2 = last ? nA : cA + (size_t)(t + 2) * kstep; const char* b2 = last ? nB : cB + (size_t)(t + 2) * kstepB;
            const char* a3 = a2 + kstep; const char* b3 = b2 + kstepB;
            if (last && has_next) S.a_ready(nxt);
            if constexpr (SP2) {
            PG8_LDB(B0, 0, 0); PG8_LDB(B1, 0, 1); PG8_SCHED; PG8_LDA(At, 0, 0); PG8_STAGE(PG8_SA(1, 1), a1 + hstep, voffA);
            PG8_WAIT_V(8); PG8_WAIT_L(0); PG8_BAR; PG8_MMA(0, 0, At, B0); PG8_MMA(0, 1, At, B1); PG8_BAR; PG8_SCHED;
            PG8_LDA(At, 0, 1); PG8_STAGE(PG8_SB(0, 0), b2, voffB); PG8_STAGE(PG8_SB(0, 1), b2 + hstep, voffB); PG8_STAGE(PG8_SA(0, 0), a2, voffA);
            PG8_WAIT_V(8); PG8_WAIT_L(0); PG8_BAR; if (!narrow_u) { PG8_MMA(1, 0, At, B0); PG8_MMA(1, 1, At, B1); } PG8_BAR; PG8_SCHED;
            PG8_LDB(B0, 1, 0); PG8_LDB(B1, 1, 1); PG8_SCHED; PG8_LDA(At, 1, 0); PG8_STAGE(PG8_SA(0, 1), a2 + hstep, voffA);
            PG8_WAIT_V(8); PG8_WAIT_L(0); PG8_BAR; PG8_MMA(0, 0, At, B0); PG8_MMA(0, 1, At, B1); PG8_BAR; PG8_SCHED;
            PG8_LDA(At, 1, 1); PG8_STAGE(PG8_SB(1, 0), b3, voffB); PG8_STAGE(PG8_SB(1, 1), b3 + hstep, voffB); PG8_STAGE(PG8_SA(1, 0), a3, voffA);
            PG8_WAIT_V(8); PG8_WAIT_L(0); PG8_BAR; if (!narrow_u) { PG8_MMA(1, 0, At, B0); PG8_MMA(1, 1, At, B1); } PG8_BAR; PG8_SCHED;
            } else {
            PG8_LDB(B0, 0, 0); PG8_SCHED; PG8_LDA(At, 0, 0); PG8_STAGE(PG8_SA(1, 1), a1 + hstep, voffA);
            PG8_WAIT_L(8); PG8_BAR; PG8_WAIT_L(0); PG8_MMA(0, 0, At, B0); PG8_BAR; PG8_SCHED;
            PG8_LDB(B1, 0, 1); PG8_STAGE(PG8_SB(0, 0), b2, voffB);
            PG8_BAR; PG8_WAIT_L(0); PG8_MMA(0, 1, At, B1); PG8_BAR;
            PG8_LDA(At, 0, 1); PG8_STAGE(PG8_SA(0, 0), a2, voffA);
            PG8_BAR; PG8_WAIT_L(0); PG8_MMA(1, 0, At, B0); PG8_BAR; PG8_SCHED;
            PG8_STAGE(PG8_SB(0, 1), b2 + hstep, voffB);
            PG8_WAIT_V(6); PG8_BAR; PG8_MMA(1, 1, At, B1); PG8_BAR;
            PG8_LDB(B0, 1, 0); PG8_SCHED; PG8_LDA(At, 1, 0); PG8_STAGE(PG8_SA(0, 1), a2 + hstep, voffA);
            PG8_WAIT_L(8); PG8_BAR; PG8_WAIT_L(0); PG8_MMA(0, 0, At, B0); PG8_BAR; PG8_SCHED;
            PG8_LDB(B1, 1, 1); PG8_STAGE(PG8_SB(1, 0), b3, voffB);
            PG8_BAR; PG8_WAIT_L(0); PG8_MMA(0, 1, At, B1); PG8_BAR;
            PG8_LDA(At, 1, 1); PG8_STAGE(PG8_SA(1, 0), a3, voffA);
            PG8_BAR; PG8_WAIT_L(0); PG8_MMA(1, 0, At, B0); PG8_BAR; PG8_SCHED;
            PG8_STAGE(PG8_SB(1, 1), b3 + hstep, voffB);
            PG8_WAIT_V(6); PG8_BAR; PG8_MMA(1, 1, At, B1); PG8_BAR;
            }
        }
        if constexpr (ALIGN_EPI) { if (wr == 0) PG8_BAR; }
        if constexpr (!Epi::AFTER_DRAIN) { E(acc, cur, wr, wc, fr, fq); S.done(cur); }
        if (!has_next) break;
#pragma unroll
        for (int a = 0; a < 2; ++a)
#pragma unroll
            for (int b = 0; b < 2; ++b)
#pragma unroll
                for (int m = 0; m < 4; ++m)
#pragma unroll
                    for (int n = 0; n < 2; ++n) acc[a][b][m][n] = (f32x4){0.f, 0.f, 0.f, 0.f};
        cur = nxt; cA = nA; cB = nB; ++ui;
        if constexpr (ALIGN_EPI) { if (wr == 1) PG8_BAR; }
    }
    PG8_WAIT_V(0);
    if constexpr (!ALIGN_EPI) { if (wr == 0) PG8_BAR; }
    PG8_BAR;
    if constexpr (Epi::AFTER_DRAIN) { E.fused(acc, cur, wr, wc, fr, fq, lds, wid, lane); S.done(cur); }
#undef PG8_SA
#undef PG8_SB
#undef PG8_STAGE
#undef PG8_LDA
#undef PG8_LDB
#undef PG8_MMA
#undef PG8_WAIT_V
#undef PG8_WAIT_L
#undef PG8_BAR
#undef PG8_SCHED
}
}
#ifndef PROBE_BLIN
#define PROBE_BLIN 0
#endif
#ifndef PROBE_ATT
#define PROBE_ATT 0
#endif
#ifndef PROBE
#define PROBE 0
#endif
#define LAS __attribute__((address_space(3)))
typedef unsigned short bf16;
typedef short bf16x8 __attribute__((ext_vector_type(8)));
typedef short s16x4 __attribute__((ext_vector_type(4)));
typedef short v4i16_t __attribute__((ext_vector_type(4)));
typedef float f32x4 __attribute__((ext_vector_type(4)));
typedef float f32x16 __attribute__((ext_vector_type(16)));
typedef unsigned u32x4 __attribute__((ext_vector_type(4)));
typedef unsigned u32x2 __attribute__((ext_vector_type(2)));

constexpr int NWAVES = 8, NTHR = 512;
constexpr int BATCH = 2, SEQ = 8192, DM = 1024, FF = 2816, M = BATCH * SEQ, NMOD = 9 * DM;
constexpr float EPS = 1e-6f;
constexpr size_t MiB = 1u << 20;
constexpr size_t WS_MOD = 1 * MiB;
constexpr size_t WS_WGU = 2 * MiB;
constexpr size_t WS_WD = WS_WGU + 8 * 11 * MiB;
constexpr size_t WS_WINAB = WS_WD + 44 * MiB;
constexpr size_t WS_WOUTAB = WS_WINAB + 8 * MiB;
constexpr size_t WS_WINC = WS_WOUTAB + 4 * MiB;
constexpr size_t WS_WOUTC = WS_WINC + 12 * MiB;
constexpr size_t WS_H = WS_WOUTC + 4 * MiB;
constexpr size_t WS_MIX = WS_H + 32 * MiB;
constexpr size_t WS_ACT = WS_MIX + 32 * MiB;
constexpr size_t WS_ROWSS = WS_ACT + 96 * MiB;
constexpr size_t WS_BIAS = WS_ROWSS + 1 * MiB;
constexpr size_t WS_END = WS_BIAS + 1 * MiB;
constexpr int BIAS_L = 28672, BIAS_MIX = 11264, BIAS_F2 = 17408;
constexpr int LDS_BYTES = 147456;

__device__ __forceinline__ unsigned pk2(float lo, float hi) { return pg8::cvt_pk_bf16(lo, hi); }
__device__ __forceinline__ float bflo(unsigned w) { return __uint_as_float(w << 16); }
__device__ __forceinline__ float bfhi(unsigned w) { return __uint_as_float(w & 0xffff0000u); }
__device__ __forceinline__ float wave_sum(float v) {
#pragma unroll
    for (int o = 1; o < 64; o <<= 1) v += __shfl_xor(v, o);
    return v;
}
__device__ __forceinline__ int fresh_tid(int wave0) { unsigned ones = ~0u; asm volatile("" : "+s"(ones)); int t = wave0 * 64 + (int)__builtin_amdgcn_mbcnt_hi(ones, __builtin_amdgcn_mbcnt_lo(ones, 0u)); asm volatile("" : "+v"(t)); return t; }
struct Args { const float* in[21]; float* out; unsigned char* ws; int ph_lo, ph_hi; };
typedef const Args __attribute__((address_space(4)))* KArgs;

__device__ __forceinline__ void tr_flush(bf16* WT, int ldk, int k0, int drow0, LAS float* scr, int lane) {
    asm volatile("s_waitcnt lgkmcnt(0)" ::: "memory");
    const int c = lane & 7;
#pragma unroll
    for (int j = 0; j < 4; ++j) { const int n = (lane >> 3) + 8 * j; const LAS float* s = scr + (8 * c) * 33 + n;
        u32x4 o; o.x = pk2(s[0 * 33], s[1 * 33]); o.y = pk2(s[2 * 33], s[3 * 33]); o.z = pk2(s[4 * 33], s[5 * 33]); o.w = pk2(s[6 * 33], s[7 * 33]);
        *(u32x4*)(WT + (size_t)(drow0 + n) * ldk + k0 + 8 * c) = o; }
    asm volatile("s_waitcnt lgkmcnt(0)" ::: "memory");
}
__device__ __forceinline__ void tr_item(const float* W, int ldn, int k0, int n0, bf16* WT, int ldk, int drow0, LAS float* scr, int lane) {
    float tv[32];
    const float* wp = W + (size_t)(k0 + (lane >> 5)) * ldn + n0 + (lane & 31);
#pragma unroll
    for (int i = 0; i < 32; ++i) tv[i] = wp[(size_t)(2 * i) * ldn];
#pragma unroll
    for (int i = 0; i < 32; ++i) scr[(2 * i + (lane >> 5)) * 33 + (lane & 31)] = tv[i];
    tr_flush(WT, ldk, k0, drow0, scr, lane);
}
__device__ __forceinline__ int glu_row(int f, int up) { return 256 * (f >> 7) + (f & 127) + (up ? 128 : 0); }

__device__ __forceinline__ void prep_phase(KArgs Ap, LAS unsigned char* lds, int tid, int lane, int wave) {
#define A (*Ap)
    const int G = gridDim.x, gw = blockIdx.x * NWAVES + wave, NGW = G * NWAVES;
    bf16* const WGU = (bf16*)(A.ws + WS_WGU); bf16* const WD = (bf16*)(A.ws + WS_WD); bf16* const WINAB = (bf16*)(A.ws + WS_WINAB);
    bf16* const WOUTAB = (bf16*)(A.ws + WS_WOUTAB); bf16* const WINC = (bf16*)(A.ws + WS_WINC); bf16* const WOUTC = (bf16*)(A.ws + WS_WOUTC);
    {
        LAS float* ca = (LAS float*)(lds);
        LAS float* red = (LAS float*)(lds + 8192);
        for (int i = tid; i < 2 * DM; i += NTHR) { const float v = A.in[1][i]; ca[i] = v / (1.0f + __expf(-v)); }
        __syncthreads();
        float* mod = (float*)(A.ws + WS_MOD);
        for (int task = blockIdx.x; task < 4 * 288; task += G) {
            const int l = task / 288, cgp = task % 288, col = lane & 31, par = lane >> 5;
            const float* wp = A.in[3] + (size_t)l * DM * NMOD + (size_t)(wave * 128 + par) * NMOD + cgp * 32 + col;
            float a0 = 0.f, a1 = 0.f;
#pragma unroll 16
            for (int k = 0; k < 64; ++k) { const float w = wp[(size_t)(2 * k) * NMOD]; a0 += ca[wave * 128 + 2 * k + par] * w; a1 += ca[DM + wave * 128 + 2 * k + par] * w; }
            a0 += __shfl_xor(a0, 32); a1 += __shfl_xor(a1, 32);
            if (lane < 32) { red[(wave * 2 + 0) * 32 + lane] = a0; red[(wave * 2 + 1) * 32 + lane] = a1; }
            __syncthreads();
            if (tid < 64) { const int b = tid >> 5, c = tid & 31; float s = 0.f;
#pragma unroll
                for (int w = 0; w < 8; ++w) s += red[(w * 2 + b) * 32 + c];
                mod[(size_t)(l * 2 + b) * NMOD + cgp * 32 + c] = s + A.in[4][(size_t)l * NMOD + cgp * 32 + c]; }
            __syncthreads();
        }
    }
    LAS float* scr = (LAS float*)(lds + wave * 16384);
    constexpr int N_FFN = 8 * 4224, N_INAB = 2 * 1024, N_OUTAB = 2 * 256, N_POOL = 2 * 256, N_INC = 2 * 1536, N_OUTC = 2 * 512;
    constexpr int NITEMS = N_FFN + N_INAB + N_OUTAB + N_POOL + N_INC + N_OUTC;
    for (int it = gw; it < NITEMS; it += NGW) {
        int r = it;
        if (r < N_FFN) { const int lj = r / 4224, q = r % 4224, which = q / 1408, q2 = q % 1408;
            if (which < 2) { const int kb = q2 / 88, nb = q2 % 88, f0 = 32 * nb;
                tr_item((which == 0 ? A.in[5] : A.in[6]) + (size_t)lj * DM * FF, FF, 64 * kb, f0, WGU + (size_t)lj * 5632 * 1024, 1024, glu_row(f0, which), scr, lane); }
            else { const int kb = q2 / 32, nb = q2 % 32; tr_item(A.in[7] + (size_t)lj * FF * DM, DM, 64 * kb, 32 * nb, WD + (size_t)lj * 1024 * FF, FF, 32 * nb, scr, lane); }
            continue; }
        r -= N_FFN;
        if (r < N_INAB) { const int e = r / 1024, q = r % 1024, kb = q / 64, nb = q % 64;
            tr_item(A.in[8] + (size_t)e * DM * 2048, 2048, 64 * kb, 32 * nb, WINAB + (size_t)e * 2048 * 1024, 1024, 32 * nb, scr, lane); continue; }
        r -= N_INAB;
        if (r < N_OUTAB) { const int e = r / 256, q = r % 256, kb = q / 32, nb = q % 32;
            tr_item(A.in[17] + (size_t)e * DM * DM, DM, 64 * kb, 32 * nb, WOUTAB + (size_t)e * DM * DM, DM, 32 * nb, scr, lane); continue; }
        r -= N_OUTAB;
        if (r < N_POOL) {
            const int e = r / 256, q = r % 256, kb = q / 32, nb = q % 32, g = kb >> 1, c0 = (kb & 1) * 64, n0 = 32 * nb;
            const float* pw = A.in[15] + ((size_t)(e * 4 + g) * 128 + c0 + lane) * 128;
            const float* ps = A.in[16] + e * 512 + g * 128;
            const float* wo = A.in[17] + (size_t)e * DM * DM + (size_t)(512 + g * 128) * DM + n0;
            float acc[32];
#pragma unroll
            for (int n = 0; n < 32; ++n) acc[n] = 0.f;
            for (int d = 0; d < 128; ++d) { const float pv = pw[d] * ps[d]; const float* wr = wo + (size_t)d * DM;
#pragma unroll
                for (int n = 0; n < 32; ++n) acc[n] += pv * wr[n]; }
#pragma unroll
            for (int n = 0; n < 32; ++n) scr[lane * 33 + n] = acc[n];
            tr_flush(WOUTAB + (size_t)e * DM * DM, DM, 512 + 64 * kb, n0, scr, lane); continue; }
        r -= N_POOL;
        if (r < N_INC) { const int o = r / 1536, q = r % 1536, kb = q / 96, nb = q % 96, c0 = 32 * nb;
            const int drow = c0 < 1024 ? c0 : (c0 < 2048 ? 1024 + glu_row(c0 - 1024, 0) : 1024 + glu_row(c0 - 2048, 1));
            tr_item(A.in[18] + (size_t)o * DM * 3072, 3072, 64 * kb, c0, WINC + (size_t)o * 3072 * 1024, 1024, drow, scr, lane); continue; }
        r -= N_INC;
        { const int o = r / 512, q = r % 512, kb = q / 32, nb = q % 32;
            tr_item(A.in[20] + (size_t)o * DM * DM, DM, 64 * kb, 32 * nb, WOUTC + (size_t)o * DM * DM, DM, 32 * nb, scr, lane); }
    }
}

#undef A
__device__ __forceinline__ void prep2_phase(KArgs Ap, int lane, int wave) {
#define A (*Ap)
    const int gw = blockIdx.x * NWAVES + wave, NGW = gridDim.x * NWAVES;
    const float* mod = (const float*)(A.ws + WS_MOD); float* bias = (float*)(A.ws + WS_BIAS);
    constexpr int ROWS_L = 5632 + 3072 + 5632, ITEMS_L = ROWS_L / 32;
    for (int it = gw; it < 4 * ITEMS_L; it += NGW) {
        const int l = it / ITEMS_L, r32 = (it % ITEMS_L) * 32, e = l >> 1;
        int j, n0, N; const bf16* W;
        if (r32 < 5632) { j = 0; n0 = r32; N = 5632; W = (const bf16*)(A.ws + WS_WGU) + (size_t)(l * 2) * 5632 * 1024; }
        else if (r32 < 5632 + 3072) { j = 1; n0 = r32 - 5632; N = (l & 1) ? 3072 : 2048; if (n0 >= N) continue;
            W = (l & 1) ? (const bf16*)(A.ws + WS_WINC) + (size_t)e * 3072 * 1024 : (const bf16*)(A.ws + WS_WINAB) + (size_t)e * 2048 * 1024; }
        else { j = 2; n0 = r32 - 5632 - 3072; N = 5632; W = (const bf16*)(A.ws + WS_WGU) + (size_t)(l * 2 + 1) * 5632 * 1024; }
        const float* sh0 = mod + (size_t)(l * 2) * NMOD + (3 * j) * DM + 16 * lane; const float* sh1 = sh0 + NMOD;
        float s0[16], s1[16];
#pragma unroll
        for (int q = 0; q < 4; ++q) { const f32x4 a = ((const f32x4*)sh0)[q], b = ((const f32x4*)sh1)[q];
            s0[4 * q] = a.x; s0[4 * q + 1] = a.y; s0[4 * q + 2] = a.z; s0[4 * q + 3] = a.w; s1[4 * q] = b.x; s1[4 * q + 1] = b.y; s1[4 * q + 2] = b.z; s1[4 * q + 3] = b.w; }
        float* bo = bias + (size_t)l * BIAS_L + (j == 0 ? 0 : (j == 1 ? BIAS_MIX : BIAS_F2));
        for (int rr = 0; rr < 32; rr += 4) {
            u32x4 w0[4], w1[4];
#pragma unroll
            for (int u = 0; u < 4; ++u) { const u32x4* wp = (const u32x4*)(W + (size_t)(n0 + rr + u) * 1024 + 16 * lane); w0[u] = wp[0]; w1[u] = wp[1]; }
#pragma unroll
            for (int u = 0; u < 4; ++u) {
                const unsigned ww[8] = {w0[u].x, w0[u].y, w0[u].z, w0[u].w, w1[u].x, w1[u].y, w1[u].z, w1[u].w};
                float a0 = 0.f, a1 = 0.f;
#pragma unroll
                for (int q = 0; q < 8; ++q) { const float lo = bflo(ww[q]), hi = bfhi(ww[q]); a0 += s0[2 * q] * lo + s0[2 * q + 1] * hi; a1 += s1[2 * q] * lo + s1[2 * q + 1] * hi; }
                a0 = wave_sum(a0); a1 = wave_sum(a1);
                if (lane == 0) { bo[n0 + rr + u] = a0; bo[N + n0 + rr + u] = a1; }
            }
        }
    }
    const float* g = A.in[2]; bf16* xg = (bf16*)(A.ws + WS_H); float* rowss = (float*)(A.ws + WS_ROWSS);
    for (int m0 = gw; m0 < M; m0 += 4 * NGW) {
        f32x4 v[4][4];
#pragma unroll
        for (int k4 = 0; k4 < 4; ++k4) { const int m = (m0 + k4 * NGW < M) ? m0 + k4 * NGW : m0; const f32x4* xr = (const f32x4*)(A.in[0] + (size_t)m * DM) + lane;
#pragma unroll
            for (int j = 0; j < 4; ++j) v[k4][j] = xr[64 * j]; }
#pragma unroll
        for (int k4 = 0; k4 < 4; ++k4) { const int m = m0 + k4 * NGW; if (m >= M) break;
            const int b = m / SEQ; const float* sc = mod + (size_t)b * NMOD + DM;
            u32x2* o8 = (u32x2*)(xg + (size_t)m * DM) + lane; float s = 0.f;
#pragma unroll
            for (int j = 0; j < 4; ++j) { const f32x4 vv = v[k4][j]; s += (vv.x * vv.x + vv.y * vv.y) + (vv.z * vv.z + vv.w * vv.w);
                const f32x4 y = vv * ((const f32x4*)g)[lane + 64 * j] * (((const f32x4*)sc)[lane + 64 * j] + 1.0f);
                u32x2 w; w.x = pk2(y.x, y.y); w.y = pk2(y.z, y.w); o8[64 * j] = w; }
            s = wave_sum(s);
            if (lane < 16) rowss[(size_t)m * 16 + lane] = (lane == 0) ? s : 0.f; }
    }
}
#undef A
__device__ __forceinline__ void pool_phase(const bf16* proj  , bf16* mix, int lane, int wave) {
    const int gw = blockIdx.x * NWAVES + wave, NGW = gridDim.x * NWAVES;
    const int g = lane >> 4, w = 2 << g;
    for (int m = gw; m < M; m += NGW) {
        const int t = m % SEQ;
        const bf16* up = proj + (size_t)m * 2048 + 1536 + 8 * lane;
        const u32x4 c = *(const u32x4*)up;
        float s[8] = {bflo(c.x), bfhi(c.x), bflo(c.y), bfhi(c.y), bflo(c.z), bfhi(c.z), bflo(c.w), bfhi(c.w)};
        float cur[8];
#pragma unroll
        for (int e = 0; e < 8; ++e) cur[e] = s[e];
        const int cnt = (t + 1 < w) ? t + 1 : w;
        u32x4 pv[15];
#pragma unroll
        for (int j = 1; j < 16; ++j) { pv[j - 1] = (u32x4){0u, 0u, 0u, 0u}; if (j < cnt) pv[j - 1] = *(const u32x4*)(up - (size_t)j * 2048); }
#pragma unroll
        for (int j = 0; j < 15; ++j) { const u32x4 p = pv[j];
            s[0] += bflo(p.x); s[1] += bfhi(p.x); s[2] += bflo(p.y); s[3] += bfhi(p.y); s[4] += bflo(p.z); s[5] += bfhi(p.z); s[6] += bflo(p.w); s[7] += bfhi(p.w); }
        const float inv = 1.0f / (float)cnt;
        u32x4 o; o.x = pk2(s[0] * inv - cur[0], s[1] * inv - cur[1]); o.y = pk2(s[2] * inv - cur[2], s[3] * inv - cur[3]);
        o.z = pk2(s[4] * inv - cur[4], s[5] * inv - cur[5]); o.w = pk2(s[6] * inv - cur[6], s[7] * inv - cur[7]);
        *(u32x4*)(mix + (size_t)m * DM + 512 + 8 * lane) = o;
    }
}

__device__ __forceinline__ void conv_phase(const bf16* __restrict__ proj  , bf16* __restrict__ mix, const float* __restrict__ cw  , int tid) {
    const int gt = blockIdx.x * NTHR + tid, NGT = gridDim.x * NTHR;
    for (int i0 = gt; i0 < M * 128; i0 += 4 * NGT)
#pragma unroll
    for (int k4 = 0; k4 < 4; ++k4) { const int i = i0 + k4 * NGT; if (i >= M * 128) break;
        const int m = i >> 7, c8 = (i & 127) * 8, t = m % SEQ;
        const bf16* bp = proj + (size_t)m * 2048 + c8; const bf16* vp = bp + 1024;
        const u32x4 bb = *(const u32x4*)bp, v0 = *(const u32x4*)vp;
        u32x4 v1 = (u32x4){0u, 0u, 0u, 0u}, v2 = (u32x4){0u, 0u, 0u, 0u};
        if (t >= 1) v1 = *(const u32x4*)(vp - 2048);
        if (t >= 2) v2 = *(const u32x4*)(vp - 4096);
        const f32x4 w0a = *(const f32x4*)(cw + c8), w0b = *(const f32x4*)(cw + c8 + 4), w1a = *(const f32x4*)(cw + 1024 + c8), w1b = *(const f32x4*)(cw + 1024 + c8 + 4),
                    w2a = *(const f32x4*)(cw + 2048 + c8), w2b = *(const f32x4*)(cw + 2048 + c8 + 4);
        float y[8];
#define CV(e, W0, W1, W2, word, HI) y[e] = (HI ? bfhi(bb.word) : bflo(bb.word)) * (W0 * (HI ? bfhi(v2.word) : bflo(v2.word)) + W1 * (HI ? bfhi(v1.word) : bflo(v1.word)) + W2 * (HI ? bfhi(v0.word) : bflo(v0.word)))
        CV(0, w0a.x, w1a.x, w2a.x, x, 0); CV(1, w0a.y, w1a.y, w2a.y, x, 1); CV(2, w0a.z, w1a.z, w2a.z, y, 0); CV(3, w0a.w, w1a.w, w2a.w, y, 1);
        CV(4, w0b.x, w1b.x, w2b.x, z, 0); CV(5, w0b.y, w1b.y, w2b.y, z, 1); CV(6, w0b.z, w1b.z, w2b.z, w, 0); CV(7, w0b.w, w1b.w, w2b.w, w, 1);
#undef CV
        u32x4 o; o.x = pk2(y[0], y[1]); o.y = pk2(y[2], y[3]); o.z = pk2(y[4], y[5]); o.w = pk2(y[6], y[7]);
        *(u32x4*)(mix + (size_t)m * DM + c8) = o;
    }
}

__device__ __forceinline__ void qknorm_phase(const bf16* proj, bf16* qkn  , const float* qkg  , int lane, int wave) {
    const int gw = blockIdx.x * NWAVES + wave, NGW = gridDim.x * NWAVES;
    const int isk = lane >> 5;
    const float* g = qkg + isk * 64 + ((16 * lane) & 63);
    float gv[16];
#pragma unroll
    for (int q = 0; q < 4; ++q) { const f32x4 a = ((const f32x4*)g)[q]; gv[4 * q] = a.x; gv[4 * q + 1] = a.y; gv[4 * q + 2] = a.z; gv[4 * q + 3] = a.w; }
    const float qs = isk ? 1.0f : 0.125f * 1.4426950408889634f;
    for (int m = gw; m < M; m += NGW) {
        const u32x4* p = (const u32x4*)(proj + (size_t)m * 2048 + 16 * lane); u32x4* po = (u32x4*)(qkn + (size_t)m * 1024 + 16 * lane);
        const u32x4 w0 = p[0], w1 = p[1];
        const unsigned ww[8] = {w0.x, w0.y, w0.z, w0.w, w1.x, w1.y, w1.z, w1.w};
        float f[16], ss = 0.f;
#pragma unroll
        for (int q = 0; q < 8; ++q) { f[2 * q] = bflo(ww[q]); f[2 * q + 1] = bfhi(ww[q]); ss += f[2 * q] * f[2 * q] + f[2 * q + 1] * f[2 * q + 1]; }
        ss += __shfl_xor(ss, 1); ss += __shfl_xor(ss, 2);
        const float rstd = (1.0f / sqrtf(ss * (1.0f / 64.0f) + EPS)) * qs;
        u32x4 o0, o1;
        o0.x = pk2(f[0] * rstd * gv[0], f[1] * rstd * gv[1]); o0.y = pk2(f[2] * rstd * gv[2], f[3] * rstd * gv[3]); o0.z = pk2(f[4] * rstd * gv[4], f[5] * rstd * gv[5]); o0.w = pk2(f[6] * rstd * gv[6], f[7] * rstd * gv[7]);
        o1.x = pk2(f[8] * rstd * gv[8], f[9] * rstd * gv[9]); o1.y = pk2(f[10] * rstd * gv[10], f[11] * rstd * gv[11]); o1.z = pk2(f[12] * rstd * gv[12], f[13] * rstd * gv[13]); o1.w = pk2(f[14] * rstd * gv[14], f[15] * rstd * gv[15]);
        po[0] = o0; po[1] = o1;
    }
}

namespace att {
constexpr int STAGE = 32768, NSTAGE = 4, OFF_V = 16384, OFF_WS = 131072 + 1024;
__device__ __forceinline__ int crow(int i, int h) { return (i & 3) + 8 * (i >> 2) + 4 * h; }
__device__ __forceinline__ s16x4 vtr(const LAS unsigned char* p) { return __builtin_bit_cast(s16x4, __builtin_amdgcn_ds_read_tr16_b64_v4i16((LAS v4i16_t*)p)); }
#define MFMA32(a, b, c) __builtin_amdgcn_mfma_f32_32x32x16_bf16((a), (b), (c), 0, 0, 0)
__device__ __forceinline__ float max3f(float a, float b, float c) { float r; asm("v_max3_f32 %0, %1, %2, %3" : "=v"(r) : "v"(a), "v"(b), "v"(c)); return r; }
__device__ __forceinline__ float max2f(float a, float b) { float r; asm("v_max_f32_e32 %0, %1, %2" : "=v"(r) : "v"(a), "v"(b)); return r; }
__device__ __forceinline__ void glds16(const void* gsrc, unsigned lds_dst) { unsigned keep;
    asm volatile("s_mov_b32 %0, m0\n\ts_mov_b32 m0, %2\n\ts_nop 0\n\tglobal_load_lds_dwordx4 %1, off\n\ts_mov_b32 m0, %0" : "=&s"(keep) : "v"(gsrc), "s"(lds_dst) : "memory"); }
#define GLDS16(gp, lp) glds16((gp), (unsigned)__builtin_amdgcn_readfirstlane((int)(unsigned)(uintptr_t)(lp)))
__device__ __forceinline__ void glds16s(const void* sbase, unsigned voff, unsigned lds_dst) { unsigned keep;
    asm volatile("s_mov_b32 %0, m0\n\ts_mov_b32 m0, %3\n\ts_nop 0\n\tglobal_load_lds_dwordx4 %1, %2\n\ts_mov_b32 m0, %0" : "=&s"(keep) : "v"(voff), "s"(sbase), "s"(lds_dst) : "memory"); }
__device__ __forceinline__ void dma_tile(LAS unsigned char* st, const bf16* proj, const bf16* qkn, size_t rowbase, int hd, int t, int wid, unsigned koff, unsigned voff) {
    const unsigned ldsb = (unsigned)__builtin_amdgcn_readfirstlane((int)(unsigned)(uintptr_t)st);
    const char* kb = (const char*)(qkn + (rowbase + (size_t)(64 * t)) * 2048 + 512 + hd * 128 + 8 * wid);
    glds16s(kb, koff, ldsb + wid * 1024);
    glds16s(kb + 128, koff, ldsb + 8192 + wid * 1024);
#pragma unroll
    for (int i = 0; i < 2; ++i) { const int s = 2 * wid + i, db = s >> 2, kvg = s & 3;
        const char* vb = (const char*)(proj + (rowbase + (size_t)(64 * t + 16 * kvg)) * 2048 + 1024 + hd * 128 + 32 * db);
        glds16s(vb, voff, ldsb + OFF_V + s * 1024); }
}

template <bool MASKED> __device__ __forceinline__ void s_step(const LAS unsigned char* kb, const bf16x8 (&qr)[4], f32x16& negm, float& mref, f32x16 (&o)[4], float& lsum, bf16x8 (&pa)[4],
                                                            LAS float* wsf, int r, int h, int thr, bool first) {
    f32x16 p0, p1;
    bf16x8 ka[4], kc[4];
#pragma unroll
    for (int d0 = 0; d0 < 4; ++d0) { ka[d0] = *(const LAS bf16x8*)(kb + d0 * 2048); kc[d0] = *(const LAS bf16x8*)(kb + d0 * 2048 + 512); }
    __builtin_amdgcn_sched_barrier(0);
    __builtin_amdgcn_s_setprio(1);
    p0 = MFMA32(ka[0], qr[0], negm); p1 = MFMA32(kc[0], qr[0], negm);
#pragma unroll
    for (int d0 = 1; d0 < 4; ++d0) { p0 = MFMA32(ka[d0], qr[d0], p0); p1 = MFMA32(kc[d0], qr[d0], p1); }
    __builtin_amdgcn_s_setprio(0);
    if (MASKED) {
#pragma unroll
        for (int i = 0; i < 16; ++i) { const int kl = crow(i, h); if (kl > thr) p0[i] = -INFINITY; if (kl + 32 > thr) p1[i] = -INFINITY; } }
    asm volatile("s_nop 15\n\ts_nop 7" : "+v"(p0), "+v"(p1));
    float mx;
    { float a = max3f(p0[0], p0[1], p1[0]), c = max3f(p0[2], p0[3], p1[1]); a = max3f(a, p1[2], p1[3]);
#pragma unroll
      for (int i = 4; i < 16; i += 4) { a = max3f(a, p0[i], p0[i + 1]); c = max3f(c, p0[i + 2], p0[i + 3]); a = max3f(a, p1[i], p1[i + 1]); c = max3f(c, p1[i + 2], p1[i + 3]); }
      mx = max2f(a, c);
      const auto rr = __builtin_amdgcn_permlane32_swap(__float_as_uint(mx), __float_as_uint(mx), false, false);
      mx = max2f(__uint_as_float(rr[0]), __uint_as_float(rr[1])); }
    if (first || __any(mx > 8.0f)) {
        const float dl = first ? mx : fmaxf(mx, 0.f), alpha = __builtin_amdgcn_exp2f(-dl);
        mref += dl;
#pragma unroll
        for (int i = 0; i < 16; ++i) { p0[i] -= dl; p1[i] -= dl; negm[i] = -mref; }
        if (h == 0) wsf[r] = alpha;
        asm volatile("s_waitcnt lgkmcnt(0)" ::: "memory");
#pragma unroll
        for (int i = 0; i < 16; ++i) { const float a = wsf[crow(i, h)];
#pragma unroll
            for (int d = 0; d < 4; ++d) o[d][i] *= a; }
        lsum *= alpha;
    }
    float ps0 = 0.f, ps1 = 0.f;
#pragma unroll
    for (int i = 0; i < 16; ++i) { p0[i] = __builtin_amdgcn_exp2f(p0[i]); p1[i] = __builtin_amdgcn_exp2f(p1[i]); ps0 += p0[i]; ps1 += p1[i]; }
    lsum += ps0 + ps1;
    u32x4 w;
    w.x = pk2(p0[0], p0[1]); w.y = pk2(p0[2], p0[3]); w.z = pk2(p0[4], p0[5]); w.w = pk2(p0[6], p0[7]); pa[0] = __builtin_bit_cast(bf16x8, w);
    w.x = pk2(p0[8], p0[9]); w.y = pk2(p0[10], p0[11]); w.z = pk2(p0[12], p0[13]); w.w = pk2(p0[14], p0[15]); pa[1] = __builtin_bit_cast(bf16x8, w);
    w.x = pk2(p1[0], p1[1]); w.y = pk2(p1[2], p1[3]); w.z = pk2(p1[4], p1[5]); w.w = pk2(p1[6], p1[7]); pa[2] = __builtin_bit_cast(bf16x8, w);
    w.x = pk2(p1[8], p1[9]); w.y = pk2(p1[10], p1[11]); w.z = pk2(p1[12], p1[13]); w.w = pk2(p1[14], p1[15]); pa[3] = __builtin_bit_cast(bf16x8, w);
}
__device__ __forceinline__ void pv_step(const LAS unsigned char* vb, const bf16x8 (&pa)[4], f32x16 (&o)[4]) {
    s16x4 vlo[4][4], vhi[4][4];
#pragma unroll
    for (int db = 0; db < 4; ++db)
#pragma unroll
        for (int s = 0; s < 4; ++s) { vlo[db][s] = vtr(vb + (db * 4 + s) * 1024); vhi[db][s] = vtr(vb + (db * 4 + s) * 1024 + 512); }
    __builtin_amdgcn_sched_barrier(0);
    __builtin_amdgcn_s_setprio(1);
#pragma unroll
    for (int db = 0; db < 4; ++db)
#pragma unroll
        for (int s = 0; s < 4; ++s) { const bf16x8 vf = __builtin_shufflevector(vlo[db][s], vhi[db][s], 0, 1, 2, 3, 4, 5, 6, 7);
            o[db] = MFMA32(pa[s], vf, o[db]); }
    __builtin_amdgcn_s_setprio(0);
}

template <int MODE  > __device__ __forceinline__ void attn_unit(LAS unsigned char* lds, const bf16* proj, const bf16* qkn, bf16* mix, int b, int hd, int qb, const float* subg  , float lam, float oscale, int tid) {
    const int lane = tid & 63, r = lane & 31, h = lane >> 5; const int wid = __builtin_amdgcn_readfirstlane(tid >> 6);
    const int sub = wid >> 2, wq = wid & 3;
    const size_t rowbase = (size_t)b * SEQ; const int q0 = qb * 128, qw = q0 + wq * 32;
    const int NT = 2 * qb + 2, ntw = (qw >> 6) + 1;
    LAS float* wsf = (LAS float*)(lds + OFF_WS) + wid * 64;
    const unsigned dkoff = (unsigned)lane * 4096u, dvoff = (unsigned)(lane >> 2) * 4096u + (unsigned)(lane & 3) * 16u;
#pragma unroll
    for (int j = 0; j < NSTAGE; ++j) if (j < NT) dma_tile(lds + j * STAGE, proj, qkn, rowbase, hd, j, wid, dkoff, dvoff);
    bf16x8 qr[4];
    { const bf16* qp = qkn + (rowbase + (size_t)(qw + r)) * 2048 + hd * 128 + sub * 64 + 8 * h;
#pragma unroll
      for (int d0 = 0; d0 < 4; ++d0) qr[d0] = *(const bf16x8*)(qp + 16 * d0); }
    f32x16 o[4], negm;
#pragma unroll
    for (int i = 0; i < 16; ++i) { o[0][i] = 0.f; o[1][i] = 0.f; o[2][i] = 0.f; o[3][i] = 0.f; negm[i] = 0.f; }
    float mref = 0.f, lsum = 0.f;
    bf16x8 pa[4];
#pragma unroll
    for (int s = 0; s < 4; ++s) pa[s] = (bf16x8){0, 0, 0, 0, 0, 0, 0, 0};
    const int vlane = (4 * h + ((lane & 15) >> 2)) * 64 + ((lane >> 4) & 1) * 32 + (lane & 3) * 8;
    const LAS unsigned char* kbase = lds + sub * 8192 + h * 1024 + r * 16;
    const LAS unsigned char* vbase = lds + OFF_V + vlane;
    asm volatile("s_waitcnt vmcnt(0)" ::: "memory");
    asm volatile("" : "+v"(qr[0]), "+v"(qr[1]), "+v"(qr[2]), "+v"(qr[3]));
    __builtin_amdgcn_s_barrier();
#define STEP_BEGIN(t_) do { const int k_ = (t_) + 2; if ((t_) >= 2 && k_ < NT) dma_tile(lds + (k_ & 3) * STAGE, proj, qkn, rowbase, hd, k_, wid, dkoff, dvoff); } while (0)
#define STEP_END(t_) do { if ((t_) >= 2 && (t_) + 2 < NT) asm volatile("s_waitcnt vmcnt(4)" ::: "memory"); else asm volatile("s_waitcnt vmcnt(0)" ::: "memory"); \
        asm volatile("s_waitcnt lgkmcnt(0)" ::: "memory"); __builtin_amdgcn_s_barrier(); } while (0)
#define KB(t_) (kbase + ((t_) & 3) * STAGE)
#define VB(t_) (vbase + ((t_) & 3) * STAGE)
    if (sub == 0) {
        int t = 0;
        for (; t < ntw - 1; ++t) { STEP_BEGIN(t); s_step<false>(KB(t), qr, negm, mref, o, lsum, pa, wsf, r, h, 0, t == 0); pv_step(VB(t), pa, o); STEP_END(t); }
        { STEP_BEGIN(t); s_step<true>(KB(t), qr, negm, mref, o, lsum, pa, wsf, r, h, qw + r - 64 * t, t == 0); pv_step(VB(t), pa, o); STEP_END(t); ++t; }
        for (; t < NT; ++t) { STEP_BEGIN(t); STEP_END(t); }
        asm volatile("s_waitcnt lgkmcnt(0)" ::: "memory"); __builtin_amdgcn_s_barrier();
    } else {
        int t = 0;
        { STEP_BEGIN(0); if (ntw > 1) s_step<false>(KB(0), qr, negm, mref, o, lsum, pa, wsf, r, h, 0, true); else s_step<true>(KB(0), qr, negm, mref, o, lsum, pa, wsf, r, h, qw + r, true); STEP_END(0); t = 1; }
        for (; t < ntw - 1; ++t) { STEP_BEGIN(t); pv_step(VB(t - 1), pa, o); s_step<false>(KB(t), qr, negm, mref, o, lsum, pa, wsf, r, h, 0, false); STEP_END(t); }
        if (t < ntw) { STEP_BEGIN(t); pv_step(VB(t - 1), pa, o); s_step<true>(KB(t), qr, negm, mref, o, lsum, pa, wsf, r, h, qw + r - 64 * t, false); STEP_END(t); ++t; }
        if (t < NT) { STEP_BEGIN(t); pv_step(VB(t - 1), pa, o); STEP_END(t); ++t; for (; t < NT; ++t) { STEP_BEGIN(t); STEP_END(t); } }
        else pv_step(VB(t - 1), pa, o);
        asm volatile("s_waitcnt lgkmcnt(0)" ::: "memory"); __builtin_amdgcn_s_barrier();
    }
#undef STEP_BEGIN
#undef STEP_END
#undef KB
#undef VB
    int lane_f = lane; asm volatile("" : "+v"(lane_f));
    const int r_f = lane_f & 31, h_f = lane_f >> 5;
    { const auto rr = __builtin_amdgcn_permlane32_swap(__float_as_uint(lsum), __float_as_uint(lsum), false, false); lsum = __uint_as_float(rr[0]) + __uint_as_float(rr[1]); }
    if (h_f == 0) wsf[r_f] = (sub ? lam : 1.0f) / lsum;
    asm volatile("s_waitcnt lgkmcnt(0)" ::: "memory");
#pragma unroll
    for (int i = 0; i < 16; ++i) { const float a = wsf[crow(i, h_f)];
#pragma unroll
        for (int d = 0; d < 4; ++d) o[d][i] *= a; }
    LAS float* xo = (LAS float*)(lds + wq * 16384);
    if (sub == 1) {
#pragma unroll
        for (int d = 0; d < 4; ++d)
#pragma unroll
            for (int i = 0; i < 16; ++i) xo[crow(i, h_f) * 128 + 32 * d + r_f] = o[d][i];
    }
    __syncthreads();
    if (sub == 0) {
#pragma unroll
        for (int d = 0; d < 4; ++d)
#pragma unroll
            for (int i = 0; i < 16; ++i) { const int a = crow(i, h_f) * 128 + 32 * d + r_f; xo[a] = o[d][i] - xo[a]; }
    }
    __syncthreads();
    if (sub == 0) {
        const int row = lane_f >> 1, half = lane_f & 1;
        const LAS f32x4* src = (const LAS f32x4*)(xo + row * 128 + half * 64);
        f32x4 v[16]; float ss = 0.f;
#pragma unroll
        for (int j = 0; j < 16; ++j) { v[j] = src[j]; ss += (v[j].x * v[j].x + v[j].y * v[j].y) + (v[j].z * v[j].z + v[j].w * v[j].w); }
        ss += __shfl_xor(ss, 1);
        const float rstd = (1.0f / sqrtf(ss * (1.0f / 128.0f) + EPS)) * oscale;
        bf16* dst = mix + (rowbase + (size_t)(qw + row)) * DM + hd * 128 + half * 64;
        const f32x4* gs = (const f32x4*)(subg + half * 64);
#pragma unroll
        for (int j = 0; j < 8; ++j) { const f32x4 a = v[2 * j] * rstd * gs[2 * j], c = v[2 * j + 1] * rstd * gs[2 * j + 1];
            u32x4 w; w.x = pk2(a.x, a.y); w.y = pk2(a.z, a.w); w.z = pk2(c.x, c.y); w.w = pk2(c.z, c.w); *(u32x4*)(dst + 8 * j) = w; }
    }
    __syncthreads();
}
}

typedef unsigned v4u __attribute__((ext_vector_type(4)));
#define XB_TMO      128
#define XB_XCNT(j)  (256  + 64 * (j))
#define XB_XSUB(j)  (1280 + 64 * (j))
#define XB_XGEN(j)  (2304 + 64 * (j))
#define XB_TOP      3328
#define XB_TOPGEN   3392
#define XCD_BAR_WORDS 3456
#define XB_SPIN_CAP (1u << 18)

__device__ __forceinline__ unsigned xb_ld(unsigned* p)              { return __hip_atomic_load(p, __ATOMIC_RELAXED, __HIP_MEMORY_SCOPE_AGENT); }
__device__ __forceinline__ unsigned xb_add(unsigned* p, unsigned v) { return __hip_atomic_fetch_add(p, v, __ATOMIC_RELAXED, __HIP_MEMORY_SCOPE_AGENT); }
__device__ __forceinline__ unsigned xb_xcc_id() { return (unsigned)__builtin_amdgcn_s_getreg((3 << 11) | 20) & 0xFu; }
#define XB_SPIN(cond, bar) do { unsigned _sp = 0; while (cond) { __builtin_amdgcn_s_sleep(1); \
    if ((++_sp & 255u) == 0u) { if (xb_ld(&(bar)[XB_TMO])) break; if (_sp > XB_SPIN_CAP) { atomicAdd(&(bar)[XB_TMO], 1u); break; } } } } while (0)

struct XcdBarrier {
    unsigned* bar; unsigned x;
    volatile LAS unsigned* st;
};

__device__ __forceinline__ XcdBarrier xcd_barrier_post(unsigned* bar, volatile LAS unsigned* st) {
    XcdBarrier b; b.bar = bar; b.x = xb_xcc_id(); b.st = st;
    if (threadIdx.x == 0) (void)xb_add(&bar[XB_XCNT(b.x)], 1u);
    return b;
}
__device__ __forceinline__ void xcd_barrier_complete(unsigned* bar, unsigned x, unsigned& nloc, unsigned& nx) {
    const unsigned G = gridDim.x * gridDim.y * gridDim.z;
    unsigned sum, cnt, mine, sp = 0u;
    for (;;) {
        sum = 0u; cnt = 0u; mine = 0u;
#pragma unroll
        for (unsigned j = 0; j < 16; ++j) { const unsigned c = xb_ld(&bar[XB_XCNT(j)]); sum += c; cnt += (c > 0u) ? 1u : 0u; mine = (j == x) ? c : mine; }
        if (sum == G) break;
        __builtin_amdgcn_s_sleep(1);
        if ((++sp & 255u) == 0u) { if (xb_ld(&bar[XB_TMO])) break; if (sp > XB_SPIN_CAP) { atomicAdd(&bar[XB_TMO], 1u); break; } }
    }
    nloc = mine > 0u ? mine : 1u; nx = cnt > 0u ? cnt : 1u;
}

__device__ __forceinline__ void xcd_barrier(const XcdBarrier& b, const bool lead  ) {
    asm volatile("s_waitcnt vmcnt(0)" ::: "memory");
    __syncthreads();
    if (lead) {
        unsigned* bar = b.bar;
        __builtin_amdgcn_s_waitcnt(0);
        unsigned nloc = b.st[0], nx = b.st[1];
        if (nloc == 0u) { xcd_barrier_complete(bar, b.x, nloc, nx); b.st[0] = nloc; b.st[1] = nx; }
        const unsigned old = xb_add(&bar[XB_XSUB(b.x)], 1u);
        const unsigned gen = old / nloc;
        if (old + 1u == (gen + 1u) * nloc) {
            __builtin_amdgcn_fence(__ATOMIC_RELEASE, "agent");
            asm volatile("s_waitcnt vmcnt(0)" ::: "memory");
            const unsigned og = xb_add(&bar[XB_TOP], 1u);
            const unsigned tg = og / nx;
            if (og + 1u == (tg + 1u) * nx) xb_add(&bar[XB_TOPGEN], 1u);
            else XB_SPIN(xb_ld(&bar[XB_TOPGEN]) == tg, bar);
            __builtin_amdgcn_fence(__ATOMIC_ACQUIRE, "agent");
            xb_add(&bar[XB_XGEN(b.x)], 1u);
            asm volatile("s_waitcnt vmcnt(0)" ::: "memory");
        } else {
            XB_SPIN(xb_ld(&bar[XB_XGEN(b.x)]) == gen, bar);
            __builtin_amdgcn_fence(__ATOMIC_ACQUIRE, "agent");
            asm volatile("s_waitcnt vmcnt(0)" ::: "memory");
        }
    }
    __syncthreads();
}

#define XL_RANK(j) (3520 + 64 * (j))
#define XL_SUB(j)  (4608 + 64 * (j))
#define XL_GEN(j)  (5696 + 64 * (j))
constexpr int CTL_ZERO_BYTES = 32768;
__device__ __forceinline__ void xcd_local_barrier(unsigned* bar, unsigned x, unsigned nloc, const bool lead, volatile LAS unsigned* genw  ) {
    asm volatile("s_waitcnt vmcnt(0)" ::: "memory");
    __syncthreads();
    if (lead) {
        __builtin_amdgcn_s_waitcnt(0);
        const unsigned gen = genw[0]; genw[0] = gen + 1u;
        const unsigned old = xb_add(&bar[XL_SUB(x)], 1u);
        if (old + 1u == (gen + 1u) * nloc) xb_add(&bar[XL_GEN(x)], 1u);
        else XB_SPIN(xb_ld(&bar[XL_GEN(x)]) == gen, bar);
        __builtin_amdgcn_fence(__ATOMIC_ACQUIRE, "agent");
        asm volatile("s_waitcnt vmcnt(0)" ::: "memory");
    }
    __syncthreads();
}

__global__ void __launch_bounds__(NTHR, 2) fwd_kernel(Args A_by_value) {
    KArgs Ap0 = (KArgs)__builtin_amdgcn_kernarg_segment_ptr();
#define A (*Ap)
    KArgs Ap = Ap0;
    extern __shared__ __attribute__((aligned(16))) unsigned char lds_raw[];
    LAS unsigned char* lds = (LAS unsigned char*)lds_raw;
    cg::grid_group grid = cg::this_grid();
    const int wave0 = __builtin_amdgcn_readfirstlane((int)threadIdx.x >> 6);
    volatile LAS unsigned* MISC = (volatile LAS unsigned*)(lds + 131072);
    if (threadIdx.x < 64) MISC[threadIdx.x] = 0u;
    __syncthreads();
    const XcdBarrier bar = xcd_barrier_post((unsigned*)A.ws, MISC + 8);
    if (threadIdx.x == 0) { MISC[16] = xb_add(&((unsigned*)A.ws)[XL_RANK(bar.x)], 1u); MISC[17] = 0u; MISC[18] = 0u; }
    __syncthreads();
    int ph = A.ph_lo, rep = 0;
    while (ph < A.ph_hi) {
#if PROBE
        int ptype; if (ph == 0) ptype = 0; else if (ph == 1) ptype = 1; else { const int s_ = (ph - 2) % 7, l_ = (ph - 2) / 7; ptype = (s_ == 0 || s_ == 5) ? 2 : (s_ == 2 ? 3 : ((s_ == 1 || s_ == 6) ? 4 : (s_ == 4 ? 5 : ((l_ & 1) ? 7 : 9)))); }
        const int nrep = 1 + ((PROBE >> ptype) & 1);
#else
        const int nrep = 1;
#endif
        Ap = Ap0; asm volatile("" : "+s"(Ap));
#define tid fresh_tid(wave0)
#define lane (fresh_tid(wave0) & 63)
#define wave wave0
        const int G = gridDim.x;
        if (ph >= 2 && (unsigned)__builtin_amdgcn_readfirstlane((int)MISC[17]) == 0u) {
            if (fresh_tid(wave0) == 0) { unsigned ok = (G % 8 == 0) ? 1u : 0u;
                for (unsigned j = 0; j < 16; ++j) { const unsigned c = xb_ld(&((unsigned*)A.ws)[XL_RANK(j)]); if (c != (j < 8 ? (unsigned)G >> 3 : 0u)) ok = 0u; }
                MISC[17] = ok ? 1u : 2u; }
            __syncthreads();
        }
        const bool teamed = (ph >= 2) && (unsigned)__builtin_amdgcn_readfirstlane((int)MISC[17]) == 1u;
        const int vc = teamed ? (int)((unsigned)__builtin_amdgcn_readfirstlane((int)MISC[16]) * 8u + bar.x) : (int)blockIdx.x;
        unsigned char* ws = A.ws; asm volatile("" : "+s"(ws));
        float* const mod = (float*)(ws + WS_MOD);
        bf16* const Hb = (bf16*)(ws + WS_H); bf16* const MIXb = (bf16*)(ws + WS_MIX); bf16* const ACTb = (bf16*)(ws + WS_ACT);
        float* const rowss = (float*)(ws + WS_ROWSS);
        if (ph == 0) { prep_phase(Ap, lds, tid, lane, wave); }
        else if (ph == 1) { prep2_phase(Ap, lane, wave); }
        else {
            const int l = (ph - 2) / 7, s = (ph - 2) % 7, e = l >> 1;
            const float* modl = mod + (size_t)l * 2 * NMOD;
            const float* xcur = (ph <= 3) ? A.in[0] : A.out;
            const float* biasl = (const float*)(ws + WS_BIAS) + (size_t)l * BIAS_L;
            if (s == 0 || s == 5 || s == 2) {
                const bf16* W; int N, ldc, pn0, colbase, act, qkn = 0; const float* bias;
                if (s != 2) { W = (const bf16*)(ws + WS_WGU) + (size_t)(l * 2 + (s == 0 ? 0 : 1)) * 5632 * 1024; N = 5632; ldc = FF; pn0 = 0; colbase = 0; act = 1; bias = biasl + (s == 0 ? 0 : BIAS_F2); }
                else if ((l & 1) == 0) { W = (const bf16*)(ws + WS_WINAB) + (size_t)e * 2048 * 1024; N = 2048; ldc = 2048; pn0 = 8; colbase = 0; act = 0; bias = biasl + BIAS_MIX; qkn = 1; }
                else { W = (const bf16*)(ws + WS_WINC) + (size_t)e * 3072 * 1024; N = 3072; ldc = 2048; pn0 = 4; colbase = 1024; act = 0; bias = biasl + BIAS_MIX; }
                pg8::Gemm g{Hb, W, M, N, DM, (PROBE_BLIN && rep + 1 < nrep) ? 1 : 0}; pg8::StaticOrder S; S.init(M, N, G, vc);
                LAS unsigned* EP = (LAS unsigned*)(lds + 131072 + 256);
                if (tid == 0) pg8::EpiMix::put(EP, ACTb, ldc, pn0, colbase, act, rowss, bias, N, qkn, A.in[9] + e * 128);
                __syncthreads();
                pg8::EpiMix E{EP};
                pg8::gemm_phase<pg8::EpiMix, pg8::StaticOrder, true, true>(lds, g, S, E, tid);
            } else if (s == 1 || s == 6 || s == 4) {
                const bf16* Ain; const bf16* W; int K; const float* gate; float gs;
                if (s != 4) { Ain = ACTb; W = (const bf16*)(ws + WS_WD) + (size_t)(l * 2 + (s == 1 ? 0 : 1)) * 1024 * FF; K = FF; gate = modl + (s == 1 ? 2 : 8) * DM; gs = 0.5f; }
                else { Ain = MIXb; W = ((l & 1) == 0 ? (const bf16*)(ws + WS_WOUTAB) : (const bf16*)(ws + WS_WOUTC)) + (size_t)e * DM * DM; K = DM; gate = modl + 5 * DM; gs = 1.0f; }
                const int nl = (s == 6) ? l + 1 : l, nj = (s == 1) ? 1 : (s == 4 ? 2 : 0);
                const int has_nxt = nl < 4, nlc = has_nxt ? nl : 3;
                const float* ng = A.in[2] + (size_t)(nlc * 3 + nj) * DM;
                const float* nsc = mod + (size_t)nlc * 2 * NMOD + (3 * nj + 1) * DM;
                pg8::Gemm g{Ain, W, M, DM, K, 0}; pg8::StaticOrder S; S.init(M, DM, G, vc);
                LAS unsigned* EP = (LAS unsigned*)(lds + 131072 + 256);
                if (tid == 0) pg8::EpiRes::put(EP, xcur, A.out, gate, (rep + 1 < nrep) ? 0.0f : gs, ng, nsc, Hb, rowss, has_nxt);
                __syncthreads();
                pg8::EpiRes E{EP};
                pg8::gemm_phase<pg8::EpiRes, pg8::StaticOrder, true, true>(lds, g, S, E, tid);
            } else {
                if ((l & 1) == 0) {
                    for (int rp = 0; rp < 1 + ((PROBE >> 6) & 1); ++rp) pool_phase(ACTb, MIXb, lane, wave);
                    const float* lq1 = A.in[10] + e * 64; const float* lk1 = A.in[11] + e * 64; const float* lq2 = A.in[12] + e * 64; const float* lk2 = A.in[13] + e * 64;
                    float s1 = 0.f, s2 = 0.f;
                    for (int i = 0; i < 64; ++i) { s1 += lq1[i] * lk1[i]; s2 += lq2[i] * lk2[i]; }
                    const float lam_init = 0.8f - 0.6f * expf(-0.3f * (float)l);
                    const float lam = expf(s1) - expf(s2) + lam_init;
                    for (int ui = 0; ui < 2; ++ui) {
                        for (int v0 = vc; v0 < 256; v0 += G) {
                            const int v = (G == 256) ? (v0 & 7) * 32 + (v0 >> 3) : v0;
                            const int bh = v >> 5, x = v & 31, qb = ui == 0 ? 63 - x : x;
#if PROBE_ATT
                            att::attn_unit<PROBE_ATT>(lds, ACTb, ACTb, MIXb, bh >> 2, bh & 3, qb, A.in[14] + e * 128, lam, 1.0f - lam_init, tid);
#endif
                            att::attn_unit<0>(lds, ACTb, ACTb, MIXb, bh >> 2, bh & 3, qb, A.in[14] + e * 128, lam, 1.0f - lam_init, tid);
                        }
                    }
                } else conv_phase(ACTb, MIXb, A.in[19] + (size_t)e * 3 * DM, tid);
            }
        }
        if (ph + 1 < A.ph_hi || rep + 1 < nrep) {
            const int s_ = (ph >= 2) ? (ph - 2) % 7 : -1;
            if (A.ph_hi > 1000000) grid.sync();
            else if (teamed && !PROBE && (s_ == 0 || s_ == 1 || s_ == 4 || s_ == 5 || s_ == 6)) xcd_local_barrier(bar.bar, bar.x, (unsigned)G >> 3, fresh_tid(wave0) == 0, MISC + 18);
            else xcd_barrier(bar, fresh_tid(wave0) == 0);
        }
        if (rep + 1 < nrep) ++rep; else { rep = 0; ++ph; }
    }
}

#ifndef PROBE
#define PROBE 0
#endif
#undef tid
#undef lane
#undef wave
#undef A
#ifndef N_LAUNCH_MODE
#define N_LAUNCH_MODE 1
#endif
extern "C" void kernel_launch(void* const* d_in, const int* in_sizes, int n_in, void* d_out, int out_size, void* d_ws, size_t ws_size, hipStream_t stream) {
    static int grid = 0;
    if (grid == 0) {
        if (n_in != 21 || out_size != M * DM || ws_size < WS_END) { fprintf(stderr, "kernel_launch: unexpected problem (n_in %d out %d ws %zu)\n", n_in, out_size, ws_size); grid = -1; return; }
        int dev = 0, cus = 0, per_cu = 0;
        hipGetDevice(&dev); hipDeviceGetAttribute(&cus, hipDeviceAttributeMultiprocessorCount, dev);
        if (hipFuncSetAttribute((const void*)fwd_kernel, hipFuncAttributeMaxDynamicSharedMemorySize, LDS_BYTES) != hipSuccess) { fprintf(stderr, "kernel_launch: hipFuncSetAttribute failed\n"); grid = -1; return; }
        if (hipOccupancyMaxActiveBlocksPerMultiprocessor(&per_cu, (const void*)fwd_kernel, NTHR, LDS_BYTES) != hipSuccess || per_cu < 1) { fprintf(stderr, "kernel_launch: occupancy query says %d\n", per_cu); per_cu = 1; }
        (void)hipGetLastError();
        grid = cus * 1;
    }
    if (grid < 0) return;
    if (hipMemsetAsync(d_ws, 0, CTL_ZERO_BYTES, stream) != hipSuccess) { fprintf(stderr, "kernel_launch: memset of the barrier words failed\n"); return; }
    Args a{};
    for (int i = 0; i < 21; ++i) a.in[i] = (const float*)d_in[i];
    a.out = (float*)d_out; a.ws = (unsigned char*)d_ws;
    constexpr int NPH = 30;
#if N_LAUNCH_MODE == 0
    for (int ph = 0; ph < NPH; ++ph) { a.ph_lo = ph; a.ph_hi = ph + 1; hipLaunchKernelGGL(fwd_kernel, dim3(grid), dim3(NTHR), LDS_BYTES, stream, a); }
#else
    a.ph_lo = 0; a.ph_hi = NPH;
    void* args[] = {&a};
    hipError_t e = hipLaunchCooperativeKernel((const void*)fwd_kernel, dim3(grid), dim3(NTHR), args, LDS_BYTES, stream);
    if (e != hipSuccess) fprintf(stderr, "cooperative launch failed: %s (grid %d)\n", hipGetErrorString(e), grid);
#endif
}
```

```cpp
#include <hip/hip_runtime.h>
#include <hip/hip_cooperative_groups.h>
#include <cstdio>
#include <cstdint>
namespace cg = cooperative_groups;
namespace pg8 {
#define PG8_LAS __attribute__((address_space(3)))
typedef unsigned short bf16_t;
typedef short bf16x8 __attribute__((ext_vector_type(8)));
typedef float f32x4 __attribute__((ext_vector_type(4)));
typedef unsigned u32x4 __attribute__((ext_vector_type(4)));
constexpr int BM = 256, BK = 64, HALF = 128, HTB = HALF * BK * 2  , STAGE_BYTES = 8 * HTB, NXCD = 8, WGM = 8;

__host__ __device__ __forceinline__ int lds_byte(int r, int c) { const int st = (r >> 4) * 2 + (c >> 5), rr = r & 15, cc = c & 31, ob = rr * 64 + cc * 2; return st * 1024 + (ob ^ (((ob >> 9) & 1) << 5)); }
__host__ __device__ __forceinline__ void stage_rc(int b, int& R, int& C) { const int st = b / 1024, sb = b % 1024, swz = sb ^ (((sb >> 9) & 1) << 5); R = (st >> 1) * 16 + swz / 64; C = (st & 1) * 32 + (swz % 64) / 2; }
__host__ __device__ __forceinline__ int perm32(int rho) { const int n = rho >> 4, i = rho & 15; return 8 * (i >> 2) + 4 * n + (i & 3); }

struct Unit { int pm, pn, half, narrow, idx; };
struct Gemm { const bf16_t* A; const bf16_t* Bt; int M, N, K; int blin; };

struct StaticOrder {
    int nM, nN, nwg, G, c, nfull, tail;
    __host__ __device__ void init(int M, int N, int G_, int c_) { nM = M / BM; nN = N / BM; nwg = nM * nN; G = G_; c = c_; nfull = nwg / G; tail = ((nwg % G) * 2 == G && (G % 16) == 0) ? 1 : 0; }
    __host__ __device__ bool next(int i, Unit& u) const {
        long L = (long)i * G + c; u.half = 0; u.narrow = 0; u.idx = i;
        if (tail && i >= nfull) { if (i > nfull) return false; const int x = c % NXCD, li = c / NXCD; L = (long)nfull * G + (li >> 1) * NXCD + x; u.half = li & 1; u.narrow = 1; }
        if (L >= nwg) return false;
        int wgid = (int)L; { const int q = nwg / NXCD, r = nwg % NXCD, xcd = wgid % NXCD, off = wgid / NXCD; wgid = (xcd < r ? xcd * (q + 1) : r * (q + 1) + (xcd - r) * q) + off; }
        const int nig = WGM * nN, gid = wgid / nig, fm = gid * WGM, gsz = (nM - fm) < WGM ? (nM - fm) : WGM;
        u.pm = fm + ((wgid % nig) % gsz); u.pn = (wgid % nig) / gsz; return true;
    }
    __device__ __forceinline__ void a_ready(const Unit&) const {}
    __device__ __forceinline__ void done(const Unit&) const {}
};

typedef float f32x2 __attribute__((ext_vector_type(2)));
typedef __bf16 bf16x2_t __attribute__((ext_vector_type(2)));
__device__ __forceinline__ unsigned cvt_pk_bf16(float lo, float hi) { f32x2 v = {lo, hi}; bf16x2_t b = __builtin_convertvector(v, bf16x2_t); return __builtin_bit_cast(unsigned, b); }
__device__ __forceinline__ float silu_f(float v) { return v * __builtin_amdgcn_rcpf(1.0f + __builtin_amdgcn_exp2f(-1.4426950408889634f * v)); }

#define PG8_GAS __attribute__((address_space(1)))
template <class T> __device__ __forceinline__ T* lds_ptr(const PG8_LAS unsigned* q) { const unsigned lo = __builtin_amdgcn_readfirstlane(q[0]), hi = __builtin_amdgcn_readfirstlane(q[1]); return (T*)(((unsigned long long)hi << 32) | lo); }
__device__ __forceinline__ int lds_int(const PG8_LAS unsigned* q) { return (int)__builtin_amdgcn_readfirstlane(q[0]); }
__device__ __forceinline__ void lds_put(PG8_LAS unsigned* q, const void* p) { const unsigned long long v = (unsigned long long)p; q[0] = (unsigned)v; q[1] = (unsigned)(v >> 32); }
struct EpiMix {
    static constexpr bool PERM = true, AFTER_DRAIN = false;
    const PG8_LAS unsigned* P;
    static __device__ __forceinline__ void put(PG8_LAS unsigned* P, bf16_t* O, int ldc, int pn0, int colbase, int act, const float* rowss, const float* bias, int N, int qkn, const float* qkg) {
        lds_put(P, O); lds_put(P + 2, rowss); lds_put(P + 4, bias); P[6] = ldc; P[7] = pn0; P[8] = colbase; P[9] = act; P[10] = N; P[11] = qkn; lds_put(P + 12, qkg); P[14] = 0xFFFFFFFFu; }
    __device__ __forceinline__ void operator()(const f32x4 (&acc)[2][2][4][2], const Unit& u, int wr, int wc, int fr, int fq) const {
        PG8_GAS bf16_t* const O = (PG8_GAS bf16_t*)lds_ptr<bf16_t>(P); const PG8_GAS float* const rowss = (const PG8_GAS float*)lds_ptr<const float>(P + 2); const PG8_GAS float* const bias = (const PG8_GAS float*)lds_ptr<const float>(P + 4);
        const int ldc = lds_int(P + 6), pn0 = lds_int(P + 7), colbase = lds_int(P + 8), act_silu = lds_int(P + 9), N = lds_int(P + 10);
        const int row0 = u.pm * BM + u.half * HALF + wr * 64 + fr; const int nai = u.narrow ? 1 : 2;
        PG8_LAS float* RS = (PG8_LAS float*)((PG8_LAS unsigned char*)P - 256 + 12288);
        if (lds_int(P + 14) != u.pm) {
            const int t = (wr * 4 + wc) * 64 + fq * 16 + fr;
            if (t < 256) { const PG8_GAS f32x4* sp = (const PG8_GAS f32x4*)(rowss + (size_t)(u.pm * BM + t) * 16);
                const f32x4 a = sp[0], b = sp[1], c = sp[2], d = sp[3];
                const float ss = ((a[0] + a[1]) + (a[2] + a[3])) + ((b[0] + b[1]) + (b[2] + b[3])) + ((c[0] + c[1]) + (c[2] + c[3])) + ((d[0] + d[1]) + (d[2] + d[3]));
                RS[t] = 1.0f / sqrtf(ss * (1.0f / 1024.0f) + 1e-6f); }
            asm volatile("s_waitcnt lgkmcnt(0)" ::: "memory"); __builtin_amdgcn_s_barrier(); asm volatile("" ::: "memory");
            if (t == 0) ((PG8_LAS unsigned*)P)[14] = (unsigned)u.pm;
        }
        float rs[2][4];
#pragma unroll
        for (int ai = 0; ai < 2; ++ai)
#pragma unroll
            for (int m = 0; m < 4; ++m) rs[ai][m] = RS[u.half * HALF + (ai < nai ? ai : 0) * HALF + wr * 64 + m * 16 + fr];
        const PG8_LAS float* bp = (const PG8_LAS float*)((PG8_LAS unsigned char*)P - 256 + (lds_int(P + 11) ? 1024 : 4096)) + u.idx * BM + wc * 32 + 8 * fq;
        f32x4 bv[2][2];
#pragma unroll
        for (int bj = 0; bj < 2; ++bj)
#pragma unroll
            for (int n = 0; n < 2; ++n) bv[bj][n] = *(const PG8_LAS f32x4*)(bp + bj * HALF + 4 * n);
        if (u.pn < pn0 && lds_int(P + 11) != 0 && u.pn < 4) {
            const PG8_GAS float* const qkg = (const PG8_GAS float*)lds_ptr<const float>(P + 12);
            PG8_LAS float* X = (PG8_LAS float*)((PG8_LAS unsigned char*)P - 256 + 4096);
            const int col0 = u.pn * BM + wc * 32 + 8 * fq;
#pragma unroll
            for (int ai = 0; ai < 2; ++ai)
#pragma unroll
                for (int m = 0; m < 4; ++m)
#pragma unroll
                    for (int bj = 0; bj < 2; ++bj) { const f32x4 v0 = acc[ai][bj][m][0] * rs[ai][m] + bv[bj][0], v1 = acc[ai][bj][m][1] * rs[ai][m] + bv[bj][1];
                        float ss = ((v0[0] * v0[0] + v0[1] * v0[1]) + (v0[2] * v0[2] + v0[3] * v0[3])) + ((v1[0] * v1[0] + v1[1] * v1[1]) + (v1[2] * v1[2] + v1[3] * v1[3]));
                        ss += __shfl_xor(ss, 16); ss += __shfl_xor(ss, 32);
                        if (fq == 0) X[((ai * HALF + wr * 64 + m * 16 + fr) * 2 + bj) * 4 + wc] = ss; }
            asm volatile("s_waitcnt lgkmcnt(0)" ::: "memory"); __builtin_amdgcn_s_barrier(); asm volatile("" ::: "memory");
            const float qs = (u.pn < 2) ? 0.125f * 1.4426950408889634f : 1.0f;
            const PG8_GAS float* gp = qkg + (u.pn < 2 ? 0 : 64) + (wc & 1) * 32 + 8 * fq;
            const f32x4 g0 = *(const PG8_GAS f32x4*)gp, g1 = *(const PG8_GAS f32x4*)(gp + 4);
#pragma unroll
            for (int ai = 0; ai < 2; ++ai)
#pragma unroll
                for (int m = 0; m < 4; ++m) { PG8_GAS bf16_t* rowp = O + (size_t)(row0 + ai * HALF + m * 16) * ldc + col0;
#pragma unroll
                    for (int bj = 0; bj < 2; ++bj) { const PG8_LAS float* xp = X + ((ai * HALF + wr * 64 + m * 16 + fr) * 2 + bj) * 4;
                        const float tot = xp[wc] + xp[wc ^ 1], rn = (1.0f / sqrtf(tot * (1.0f / 64.0f) + 1e-6f)) * qs;
                        const f32x4 v0 = (acc[ai][bj][m][0] * rs[ai][m] + bv[bj][0]) * rn * g0, v1 = (acc[ai][bj][m][1] * rs[ai][m] + bv[bj][1]) * rn * g1;
                        u32x4 w; w.x = cvt_pk_bf16(v0[0], v0[1]); w.y = cvt_pk_bf16(v0[2], v0[3]); w.z = cvt_pk_bf16(v1[0], v1[1]); w.w = cvt_pk_bf16(v1[2], v1[3]);
                        *(PG8_GAS u32x4*)(rowp + bj * HALF) = w; } }
        } else if (u.pn < pn0) {
            const int col0 = u.pn * BM + wc * 32 + 8 * fq;
#pragma unroll
            for (int ai = 0; ai < 2; ++ai) if (ai < nai)
#pragma unroll
                for (int m = 0; m < 4; ++m) { PG8_GAS bf16_t* rowp = O + (size_t)(row0 + ai * HALF + m * 16) * ldc + col0;
#pragma unroll
                    for (int bj = 0; bj < 2; ++bj) { const f32x4 v0 = acc[ai][bj][m][0] * rs[ai][m] + bv[bj][0], v1 = acc[ai][bj][m][1] * rs[ai][m] + bv[bj][1];
                        u32x4 w; w.x = cvt_pk_bf16(v0[0], v0[1]); w.y = cvt_pk_bf16(v0[2], v0[3]); w.z = cvt_pk_bf16(v1[0], v1[1]); w.w = cvt_pk_bf16(v1[2], v1[3]);
                        *(PG8_GAS u32x4*)(rowp + bj * HALF) = w; } }
        } else {
            const int col0 = colbase + (u.pn - pn0) * HALF + wc * 32 + 8 * fq;
#pragma unroll
            for (int ai = 0; ai < 2; ++ai) if (ai < nai)
#pragma unroll
                for (int m = 0; m < 4; ++m) { PG8_GAS bf16_t* rowp = O + (size_t)(row0 + ai * HALF + m * 16) * ldc + col0;
                    f32x4 g0 = acc[ai][0][m][0] * rs[ai][m] + bv[0][0], g1 = acc[ai][0][m][1] * rs[ai][m] + bv[0][1]; const f32x4 u0 = acc[ai][1][m][0] * rs[ai][m] + bv[1][0], u1 = acc[ai][1][m][1] * rs[ai][m] + bv[1][1];
                    if (act_silu) {
#pragma unroll
                        for (int e = 0; e < 4; ++e) { g0[e] = silu_f(g0[e]); g1[e] = silu_f(g1[e]); } }
                    g0 = g0 * u0; g1 = g1 * u1;
                    u32x4 w; w.x = cvt_pk_bf16(g0[0], g0[1]); w.y = cvt_pk_bf16(g0[2], g0[3]); w.z = cvt_pk_bf16(g1[0], g1[1]); w.w = cvt_pk_bf16(g1[2], g1[3]);
                    *(PG8_GAS u32x4*)rowp = w; }
        }
    }
};
struct EpiRes {
    static constexpr bool PERM = true, AFTER_DRAIN = false;
    const PG8_LAS unsigned* P;
    static constexpr int gstride = 9216, rows_per_batch = 8192;
    static __device__ __forceinline__ void put(PG8_LAS unsigned* P, const float* base, float* out, const float* gate, float gs, const float* nxt_g, const float* nxt_scale, bf16_t* xg, float* rowss, int has_nxt) {
        lds_put(P, base); lds_put(P + 2, out); lds_put(P + 4, gate); lds_put(P + 6, nxt_g); lds_put(P + 8, nxt_scale); lds_put(P + 10, xg); lds_put(P + 12, rowss); P[14] = __float_as_uint(gs); P[15] = has_nxt; }
    __device__ __forceinline__ void operator()(const f32x4 (&acc)[2][2][4][2], const Unit& u, int wr, int wc, int fr, int fq) const {
        const PG8_GAS float* const base = (const PG8_GAS float*)lds_ptr<const float>(P); PG8_GAS float* const out = (PG8_GAS float*)lds_ptr<float>(P + 2); const PG8_GAS float* const gate = (const PG8_GAS float*)lds_ptr<const float>(P + 4);
        const PG8_GAS float* const nxt_g = (const PG8_GAS float*)lds_ptr<const float>(P + 6); const PG8_GAS float* const nxt_scale = (const PG8_GAS float*)lds_ptr<const float>(P + 8);
        PG8_GAS bf16_t* const xg = (PG8_GAS bf16_t*)lds_ptr<bf16_t>(P + 10); PG8_GAS float* const rowss = (PG8_GAS float*)lds_ptr<float>(P + 12);
        const float gs = __uint_as_float((unsigned)lds_int(P + 14)); const int has_nxt = lds_int(P + 15);
        const int row0 = u.pm * BM + wr * 64 + fr, col0 = u.pn * BM + wc * 32 + 8 * fq;
        const int b = (u.pm * BM) / rows_per_batch;
        const PG8_GAS float* gp = gate + (size_t)b * gstride + col0;
        f32x4 bx[3][2][2];
#define PG8_LDROW(it_, buf_) do { const size_t off_ = (size_t)(row0 + ((it_) >> 2) * HALF + ((it_) & 3) * 16) * 1024 + col0; \
            _Pragma("unroll") for (int bj = 0; bj < 2; ++bj) { bx[buf_][bj][0] = *(const PG8_GAS f32x4*)(base + off_ + bj * HALF); bx[buf_][bj][1] = *(const PG8_GAS f32x4*)(base + off_ + bj * HALF + 4); } } while (0)
        PG8_LDROW(0, 0); PG8_LDROW(1, 1);
        f32x4 gv[2][2], gm[2][2];
#pragma unroll
        for (int bj = 0; bj < 2; ++bj)
#pragma unroll
            for (int n = 0; n < 2; ++n) { gv[bj][n] = *(const PG8_GAS f32x4*)(gp + bj * HALF + 4 * n) * gs;
                gm[bj][n] = *(const PG8_GAS f32x4*)(nxt_g + col0 + bj * HALF + 4 * n) * (*(const PG8_GAS f32x4*)(nxt_scale + (size_t)b * gstride + col0 + bj * HALF + 4 * n) + 1.0f); }
#pragma unroll
        for (int it = 0; it < 8; ++it) { const int ai = it >> 2, m = it & 3; const int row = row0 + ai * HALF + m * 16; const size_t off = (size_t)row * 1024 + col0; float ss = 0.f;
            if (it + 2 < 8) PG8_LDROW(it + 2, (it + 2) % 3);
#pragma unroll
            for (int bj = 0; bj < 2; ++bj) {
                const f32x4 x0 = bx[it % 3][bj][0] + gv[bj][0] * acc[ai][bj][m][0], x1 = bx[it % 3][bj][1] + gv[bj][1] * acc[ai][bj][m][1];
                *(PG8_GAS f32x4*)(out + off + bj * HALF) = x0; *(PG8_GAS f32x4*)(out + off + bj * HALF + 4) = x1;
                if (has_nxt) { ss += ((x0[0] * x0[0] + x0[1] * x0[1]) + (x0[2] * x0[2] + x0[3] * x0[3])) + ((x1[0] * x1[0] + x1[1] * x1[1]) + (x1[2] * x1[2] + x1[3] * x1[3]));
                    const f32x4 y0 = x0 * gm[bj][0], y1 = x1 * gm[bj][1];
                    u32x4 w; w.x = cvt_pk_bf16(y0[0], y0[1]); w.y = cvt_pk_bf16(y0[2], y0[3]); w.z = cvt_pk_bf16(y1[0], y1[1]); w.w = cvt_pk_bf16(y1[2], y1[3]);
                    *(PG8_GAS u32x4*)(xg + off + bj * HALF) = w; } }
            if (has_nxt) { ss += __shfl_xor(ss, 16); ss += __shfl_xor(ss, 32); if (fq == 0) rowss[(size_t)row * 16 + u.pn * 4 + wc] = ss; } }
#undef PG8_LDROW
    }
};

template <class Epi, class Sched, bool ALIGN_EPI = false, bool SP2 = false>
__device__ __forceinline__ void gemm_phase(PG8_LAS unsigned char* lds, const Gemm g, const Sched& S, const Epi& E, const int tid_in) {
    int tid_o = tid_in; asm volatile("" : "+v"(tid_o));
    const int tid = tid_o, wid = __builtin_amdgcn_readfirstlane(tid >> 6), lane = tid & 63, wr = wid >> 2, wc = wid & 3, fr = lane & 15, fq = lane >> 4;
    const int K = g.K, nt = K / BK;
    unsigned voffA[2], voffB[2];
#pragma unroll
    for (int i = 0; i < 2; ++i) { int R, C; stage_rc(tid * 16 + i * 8192, R, C); const int Rb = Epi::PERM ? ((R & ~31) + perm32(R & 31)) : R;
        voffA[i] = (unsigned)(R * K + C) * 2u; voffB[i] = (g.blin & 1) ? (unsigned)(tid * 16 + i * 8192) : (unsigned)(Rb * K + C) * 2u; }
    const size_t kstep = (size_t)(BK * 2);
    const size_t kstepB = (g.blin & 1) ? (size_t)16384 : kstep;
    const size_t hstep = (size_t)HALF * K * 2;
    const size_t tstep = 2 * hstep;
    const unsigned ldsbase = (unsigned)__builtin_amdgcn_readfirstlane((int)(unsigned)(uintptr_t)lds);
    const unsigned ldsw = (unsigned)wid * 1024u;
    const int aoff = lds_byte(wr * 64 + fr, fq * 8), boff = lds_byte(wc * 32 + fr, fq * 8);
#define PG8_SA(b, h) (((b) * 2 + (h)) * HTB)
#define PG8_SB(b, h) ((4 + (b) * 2 + (h)) * HTB)
#define PG8_STAGE(bufoff, gbase, voff) do { _Pragma("unroll") for (int _i = 0; _i < 2; ++_i) { unsigned keep_; \
        asm volatile("s_mov_b32 %0, m0\n\ts_mov_b32 m0, %3\n\ts_nop 0\n\tglobal_load_lds_dwordx4 %1, %2\n\ts_mov_b32 m0, %0" : "=&s"(keep_) \
            : "v"((voff)[_i]), "s"((const char*)(gbase)), "s"(ldsbase + (unsigned)(bufoff) + ldsw + (unsigned)(_i * 8192)) : "memory"); } } while (0)
#define PG8_LDA(dst, b, h) do { _Pragma("unroll") for (int m = 0; m < 4; ++m) _Pragma("unroll") for (int k = 0; k < 2; ++k) dst[m][k] = *(const PG8_LAS bf16x8*)(lds + PG8_SA(b, h) + aoff + m * 2048 + k * 1024); } while (0)
#define PG8_LDB(dst, b, h) do { _Pragma("unroll") for (int n = 0; n < 2; ++n) _Pragma("unroll") for (int k = 0; k < 2; ++k) dst[n][k] = *(const PG8_LAS bf16x8*)(lds + PG8_SB(b, h) + boff + n * 2048 + k * 1024); } while (0)
#define PG8_MMA(ai, bj, At, Bt) do { __builtin_amdgcn_s_setprio(1); _Pragma("unroll") for (int m = 0; m < 4; ++m) _Pragma("unroll") for (int n = 0; n < 2; ++n) _Pragma("unroll") for (int k = 0; k < 2; ++k) \
        acc[ai][bj][m][n] = __builtin_amdgcn_mfma_f32_16x16x32_bf16(Bt[n][k], At[m][k], acc[ai][bj][m][n], 0, 0, 0); __builtin_amdgcn_s_setprio(0); } while (0)
#define PG8_WAIT_V(n) asm volatile("s_waitcnt vmcnt(" #n ")" ::: "memory")
#define PG8_WAIT_L(n) asm volatile("s_waitcnt lgkmcnt(" #n ")" ::: "memory")
#define PG8_BAR __builtin_amdgcn_s_barrier()
#define PG8_SCHED __builtin_amdgcn_sched_barrier(0)
    Unit cur, nxt; int ui = 0;
    if (!S.next(0, cur)) return;
    f32x4 acc[2][2][4][2];
#pragma unroll
    for (int a = 0; a < 2; ++a)
#pragma unroll
        for (int b = 0; b < 2; ++b)
#pragma unroll
            for (int m = 0; m < 4; ++m)
#pragma unroll
                for (int n = 0; n < 2; ++n) acc[a][b][m][n] = (f32x4){0.f, 0.f, 0.f, 0.f};
    bf16x8 At[4][2], B0[2][2], B1[2][2];
    const char* cA = (const char*)g.A + (size_t)cur.pm * tstep + (size_t)cur.half * hstep; const char* cB = (const char*)g.Bt + (size_t)cur.pn * tstep;
    S.a_ready(cur);
    if constexpr (SP2) {
        PG8_STAGE(PG8_SB(0, 0), cB, voffB); PG8_STAGE(PG8_SB(0, 1), cB + hstep, voffB); PG8_STAGE(PG8_SA(0, 0), cA, voffA); PG8_STAGE(PG8_SA(0, 1), cA + hstep, voffA);
        if (wr == 1) PG8_BAR;
        PG8_WAIT_V(2); PG8_BAR;
        PG8_STAGE(PG8_SB(1, 0), cB + kstepB, voffB); PG8_STAGE(PG8_SA(1, 0), cA + kstep, voffA); PG8_STAGE(PG8_SB(1, 1), cB + hstep + kstepB, voffB);
        PG8_WAIT_V(6); PG8_BAR;
    } else {
        PG8_STAGE(PG8_SB(0, 0), cB, voffB); PG8_STAGE(PG8_SA(0, 0), cA, voffA); PG8_STAGE(PG8_SB(0, 1), cB + hstep, voffB); PG8_STAGE(PG8_SA(0, 1), cA + hstep, voffA);
        if (wr == 1) PG8_BAR;
        PG8_WAIT_V(4); PG8_BAR;
        PG8_STAGE(PG8_SB(1, 0), cB + kstepB, voffB); PG8_STAGE(PG8_SA(1, 0), cA + kstep, voffA); PG8_STAGE(PG8_SB(1, 1), cB + hstep + kstepB, voffB);
        PG8_WAIT_V(6); PG8_BAR;
    }
    for (;;) {
        const bool has_next = S.next(ui + 1, nxt);
        const char* nA = has_next ? (const char*)g.A + (size_t)nxt.pm * tstep + (size_t)nxt.half * hstep : cA; const char* nB = has_next ? (const char*)g.Bt + (size_t)nxt.pn * tstep : cB;
        const bool narrow_u = cur.narrow != 0;
        for (int t = 0; t < nt; t += 2) {
            const bool last = (t == nt - 2);
            const char* a1 = cA + (size_t)(t + 1) * kstep;
            const char* a2 = last ? nA : cA + (size_t)(t + 2) * kstep; const char* b2 = last ? nB : cB + (size_t)(t + 2) * kstepB;
            const char* a3 = a2 + kstep; const char* b3 = b2 + kstepB;
            if (last && has_next) S.a_ready(nxt);
            if constexpr (SP2) {
            PG8_LDB(B0, 0, 0); PG8_LDB(B1, 0, 1); PG8_SCHED; PG8_LDA(At, 0, 0); PG8_STAGE(PG8_SA(1, 1), a1 + hstep, voffA);
            PG8_WAIT_V(8); PG8_WAIT_L(0); PG8_BAR; PG8_MMA(0, 0, At, B0); PG8_MMA(0, 1, At, B1); PG8_BAR; PG8_SCHED;
            PG8_LDA(At, 0, 1); PG8_STAGE(PG8_SB(0, 0), b2, voffB); PG8_STAGE(PG8_SB(0, 1), b2 + hstep, voffB); PG8_STAGE(PG8_SA(0, 0), a2, voffA);
            PG8_WAIT_V(8); PG8_WAIT_L(0); PG8_BAR; if (!narrow_u) { PG8_MMA(1, 0, At, B0); PG8_MMA(1, 1, At, B1); } PG8_BAR; PG8_SCHED;
            PG8_LDB(B0, 1, 0); PG8_LDB(B1, 1, 1); PG8_SCHED; PG8_LDA(At, 1, 0); PG8_STAGE(PG8_SA(0, 1), a2 + hstep, voffA);
            PG8_WAIT_V(8); PG8_WAIT_L(0); PG8_BAR; PG8_MMA(0, 0, At, B0); PG8_MMA(0, 1, At, B1); PG8_BAR; PG8_SCHED;
            PG8_LDA(At, 1, 1); PG8_STAGE(PG8_SB(1, 0), b3, voffB); PG8_STAGE(PG8_SB(1, 1), b3 + hstep, voffB); PG8_STAGE(PG8_SA(1, 0), a3, voffA);
            PG8_WAIT_V(8); PG8_WAIT_L(0); PG8_BAR; if (!narrow_u) { PG8_MMA(1, 0, At, B0); PG8_MMA(1, 1, At, B1); } PG8_BAR; PG8_SCHED;
            } else {
            PG8_LDB(B0, 0, 0); PG8_SCHED; PG8_LDA(At, 0, 0); PG8_STAGE(PG8_SA(1, 1), a1 + hstep, voffA);
            PG8_WAIT_L(8); PG8_BAR; PG8_WAIT_L(0); PG8_MMA(0, 0, At, B0); PG8_BAR; PG8_SCHED;
            PG8_LDB(B1, 0, 1); PG8_STAGE(PG8_SB(0, 0), b2, voffB);
            PG8_BAR; PG8_WAIT_L(0); PG8_MMA(0, 1, At, B1); PG8_BAR;
            PG8_LDA(At, 0, 1); PG8_STAGE(PG8_SA(0, 0), a2, voffA);
            PG8_BAR; PG8_WAIT_L(0); PG8_MMA(1, 0, At, B0); PG8_BAR; PG8_SCHED;
            PG8_STAGE(PG8_SB(0, 1), b2 + hstep, voffB);
            PG8_WAIT_V(6); PG8_BAR; PG8_MMA(1, 1, At, B1); PG8_BAR;
            PG8_LDB(B0, 1, 0); PG8_SCHED; PG8_LDA(At, 1, 0); PG8_STAGE(PG8_SA(0, 1), a2 + hstep, voffA);
            PG8_WAIT_L(8); PG8_BAR; PG8_WAIT_L(0); PG8_MMA(0, 0, At, B0); PG8_BAR; PG8_SCHED;
            PG8_LDB(B1, 1, 1); PG8_STAGE(PG8_SB(1, 0), b3, voffB);
            PG8_BAR; PG8_WAIT_L(0); PG8_MMA(0, 1, At, B1); PG8_BAR;
            PG8_LDA(At, 1, 1); PG8_STAGE(PG8_SA(1, 0), a3, voffA);
            PG8_BAR; PG8_WAIT_L(0); PG8_MMA(1, 0, At, B0); PG8_BAR; PG8_SCHED;
            PG8_STAGE(PG8_SB(1, 1), b3 + hstep, voffB);
            PG8_WAIT_V(6); PG8_BAR; PG8_MMA(1, 1, At, B1); PG8_BAR;
            }
        }
        if constexpr (ALIGN_EPI) { if (wr == 0) PG8_BAR; }
        if constexpr (!Epi::AFTER_DRAIN) { E(acc, cur, wr, wc, fr, fq); S.done(cur); }
        if (!has_next) break;
#pragma unroll
        for (int a = 0; a < 2; ++a)
#pragma unroll
            for (int b = 0; b < 2; ++b)
#pragma unroll
                for (int m = 0; m < 4; ++m)
#pragma unroll
                    for (int n = 0; n < 2; ++n) acc[a][b][m][n] = (f32x4){0.f, 0.f, 0.f, 0.f};
        cur = nxt; cA = nA; cB = nB; ++ui;
        if constexpr (ALIGN_EPI) { if (wr == 1) PG8_BAR; }
    }
    PG8_WAIT_V(0);
    if constexpr (!ALIGN_EPI) { if (wr == 0) PG8_BAR; }
    PG8_BAR;
    if constexpr (Epi::AFTER_DRAIN) { E.fused(acc, cur, wr, wc, fr, fq, lds, wid, lane); S.done(cur); }
#undef PG8_SA
#undef PG8_SB
#undef PG8_STAGE
#undef PG8_LDA
#undef PG8_LDB
#undef PG8_MMA
#undef PG8_WAIT_V
#undef PG8_WAIT_L
#undef PG8_BAR
#undef PG8_SCHED
}
}
#ifndef PROBE_BLIN
#define PROBE_BLIN 0
#endif
#ifndef PROBE_ATT
#define PROBE_ATT 0
#endif
#ifndef PROBE
#define PROBE 0
#endif
#define LAS __attribute__((address_space(3)))
typedef unsigned short bf16;
typedef short bf16x8 __attribute__((ext_vector_type(8)));
typedef short s16x4 __attribute__((ext_vector_type(4)));
typedef short v4i16_t __attribute__((ext_vector_type(4)));
typedef float f32x4 __attribute__((ext_vector_type(4)));
typedef float f32x16 __attribute__((ext_vector_type(16)));
typedef unsigned u32x4 __attribute__((ext_vector_type(4)));
typedef unsigned u32x2 __attribute__((ext_vector_type(2)));

constexpr int NWAVES = 8, NTHR = 512;
constexpr int BATCH = 2, SEQ = 8192, DM = 1024, FF = 2816, M = BATCH * SEQ, NMOD = 9 * DM;
constexpr float EPS = 1e-6f;
constexpr size_t MiB = 1u << 20;
constexpr size_t WS_MOD = 1 * MiB;
constexpr size_t WS_WGU = 2 * MiB;
constexpr size_t WS_WD = WS_WGU + 8 * 11 * MiB;
constexpr size_t WS_WINAB = WS_WD + 44 * MiB;
constexpr size_t WS_WOUTAB = WS_WINAB + 8 * MiB;
constexpr size_t WS_WINC = WS_WOUTAB + 4 * MiB;
constexpr size_t WS_WOUTC = WS_WINC + 12 * MiB;
constexpr size_t WS_H = WS_WOUTC + 4 * MiB;
constexpr size_t WS_MIX = WS_H + 32 * MiB;
constexpr size_t WS_ACT = WS_MIX + 32 * MiB;
constexpr size_t WS_ROWSS = WS_ACT + 96 * MiB;
constexpr size_t WS_BIAS = WS_ROWSS + 1 * MiB;
constexpr size_t WS_END = WS_BIAS + 1 * MiB;
constexpr int BIAS_L = 28672, BIAS_MIX = 11264, BIAS_F2 = 17408;
constexpr int LDS_BYTES = 147456;

__device__ __forceinline__ unsigned pk2(float lo, float hi) { return pg8::cvt_pk_bf16(lo, hi); }
__device__ __forceinline__ float bflo(unsigned w) { return __uint_as_float(w << 16); }
__device__ __forceinline__ float bfhi(unsigned w) { return __uint_as_float(w & 0xffff0000u); }
__device__ __forceinline__ float wave_sum(float v) {
#pragma unroll
    for (int o = 1; o < 64; o <<= 1) v += __shfl_xor(v, o);
    return v;
}
__device__ __forceinline__ int fresh_tid(int wave0) { unsigned ones = ~0u; asm volatile("" : "+s"(ones)); int t = wave0 * 64 + (int)__builtin_amdgcn_mbcnt_hi(ones, __builtin_amdgcn_mbcnt_lo(ones, 0u)); asm volatile("" : "+v"(t)); return t; }
struct Args { const float* in[21]; float* out; unsigned char* ws; int ph_lo, ph_hi; };
typedef const Args __attribute__((address_space(4)))* KArgs;

__device__ __forceinline__ void tr_flush(bf16* WT, int ldk, int k0, int drow0, LAS float* scr, int lane) {
    asm volatile("s_waitcnt lgkmcnt(0)" ::: "memory");
    const int c = lane & 7;
#pragma unroll
    for (int j = 0; j < 4; ++j) { const int n = (lane >> 3) + 8 * j; const LAS float* s = scr + (8 * c) * 33 + n;
        u32x4 o; o.x = pk2(s[0 * 33], s[1 * 33]); o.y = pk2(s[2 * 33], s[3 * 33]); o.z = pk2(s[4 * 33], s[5 * 33]); o.w = pk2(s[6 * 33], s[7 * 33]);
        *(u32x4*)(WT + (size_t)(drow0 + n) * ldk + k0 + 8 * c) = o; }
    asm volatile("s_waitcnt lgkmcnt(0)" ::: "memory");
}
__device__ __forceinline__ void tr_item(const float* W, int ldn, int k0, int n0, bf16* WT, int ldk, int drow0, LAS float* scr, int lane) {
    float tv[32];
    const float* wp = W + (size_t)(k0 + (lane >> 5)) * ldn + n0 + (lane & 31);
#pragma unroll
    for (int i = 0; i < 32; ++i) tv[i] = wp[(size_t)(2 * i) * ldn];
#pragma unroll
    for (int i = 0; i < 32; ++i) scr[(2 * i + (lane >> 5)) * 33 + (lane & 31)] = tv[i];
    tr_flush(WT, ldk, k0, drow0, scr, lane);
}
__device__ __forceinline__ int glu_row(int f, int up) { return 256 * (f >> 7) + (f & 127) + (up ? 128 : 0); }

__device__ __forceinline__ void prep_phase(KArgs Ap, LAS unsigned char* lds, int tid, int lane, int wave) {
#define A (*Ap)
    const int G = gridDim.x, gw = blockIdx.x * NWAVES + wave, NGW = G * NWAVES;
    bf16* const WGU = (bf16*)(A.ws + WS_WGU); bf16* const WD = (bf16*)(A.ws + WS_WD); bf16* const WINAB = (bf16*)(A.ws + WS_WINAB);
    bf16* const WOUTAB = (bf16*)(A.ws + WS_WOUTAB); bf16* const WINC = (bf16*)(A.ws + WS_WINC); bf16* const WOUTC = (bf16*)(A.ws + WS_WOUTC);
    {
        LAS float* ca = (LAS float*)(lds);
        LAS float* red = (LAS float*)(lds + 8192);
        for (int i = tid; i < 2 * DM; i += NTHR) { const float v = A.in[1][i]; ca[i] = v / (1.0f + __expf(-v)); }
        __syncthreads();
        float* mod = (float*)(A.ws + WS_MOD);
        for (int task = blockIdx.x; task < 4 * 288; task += G) {
            const int l = task / 288, cgp = task % 288, col = lane & 31, par = lane >> 5;
            const float* wp = A.in[3] + (size_t)l * DM * NMOD + (size_t)(wave * 128 + par) * NMOD + cgp * 32 + col;
            float a0 = 0.f, a1 = 0.f;
#pragma unroll 16
            for (int k = 0; k < 64; ++k) { const float w = wp[(size_t)(2 * k) * NMOD]; a0 += ca[wave * 128 + 2 * k + par] * w; a1 += ca[DM + wave * 128 + 2 * k + par] * w; }
            a0 += __shfl_xor(a0, 32); a1 += __shfl_xor(a1, 32);
            if (lane < 32) { red[(wave * 2 + 0) * 32 + lane] = a0; red[(wave * 2 + 1) * 32 + lane] = a1; }
            __syncthreads();
            if (tid < 64) { const int b = tid >> 5, c = tid & 31; float s = 0.f;
#pragma unroll
                for (int w = 0; w < 8; ++w) s += red[(w * 2 + b) * 32 + c];
                mod[(size_t)(l * 2 + b) * NMOD + cgp * 32 + c] = s + A.in[4][(size_t)l * NMOD + cgp * 32 + c]; }
            __syncthreads();
        }
    }
    LAS float* scr = (LAS float*)(lds + wave * 16384);
    constexpr int N_FFN = 8 * 4224, N_INAB = 2 * 1024, N_OUTAB = 2 * 256, N_POOL = 2 * 256, N_INC = 2 * 1536, N_OUTC = 2 * 512;
    constexpr int NITEMS = N_FFN + N_INAB + N_OUTAB + N_POOL + N_INC + N_OUTC;
    for (int it = gw; it < NITEMS; it += NGW) {
        int r = it;
        if (r < N_FFN) { const int lj = r / 4224, q = r % 4224, which = q / 1408, q2 = q % 1408;
            if (which < 2) { const int kb = q2 / 88, nb = q2 % 88, f0 = 32 * nb;
                tr_item((which == 0 ? A.in[5] : A.in[6]) + (size_t)lj * DM * FF, FF, 64 * kb, f0, WGU + (size_t)lj * 5632 * 1024, 1024, glu_row(f0, which), scr, lane); }
            else { const int kb = q2 / 32, nb = q2 % 32; tr_item(A.in[7] + (size_t)lj * FF * DM, DM, 64 * kb, 32 * nb, WD + (size_t)lj * 1024 * FF, FF, 32 * nb, scr, lane); }
            continue; }
        r -= N_FFN;
        if (r < N_INAB) { const int e = r / 1024, q = r % 1024, kb = q / 64, nb = q % 64;
            tr_item(A.in[8] + (size_t)e * DM * 2048, 2048, 64 * kb, 32 * nb, WINAB + (size_t)e * 2048 * 1024, 1024, 32 * nb, scr, lane); continue; }
        r -= N_INAB;
        if (r < N_OUTAB) { const int e = r / 256, q = r % 256, kb = q / 32, nb = q % 32;
            tr_item(A.in[17] + (size_t)e * DM * DM, DM, 64 * kb, 32 * nb, WOUTAB + (size_t)e * DM * DM, DM, 32 * nb, scr, lane); continue; }
        r -= N_OUTAB;
        if (r < N_POOL) {
            const int e = r / 256, q = r % 256, kb = q / 32, nb = q % 32, g = kb >> 1, c0 = (kb & 1) * 64, n0 = 32 * nb;
            const float* pw = A.in[15] + ((size_t)(e * 4 + g) * 128 + c0 + lane) * 128;
            const float* ps = A.in[16] + e * 512 + g * 128;
            const float* wo = A.in[17] + (size_t)e * DM * DM + (size_t)(512 + g * 128) * DM + n0;
            float acc[32];
#pragma unroll
            for (int n = 0; n < 32; ++n) acc[n] = 0.f;
            for (int d = 0; d < 128; ++d) { const float pv = pw[d] * ps[d]; const float* wr = wo + (size_t)d * DM;
#pragma unroll
                for (int n = 0; n < 32; ++n) acc[n] += pv * wr[n]; }
#pragma unroll
            for (int n = 0; n < 32; ++n) scr[lane * 33 + n] = acc[n];
            tr_flush(WOUTAB + (size_t)e * DM * DM, DM, 512 + 64 * kb, n0, scr, lane); continue; }
        r -= N_POOL;
        if (r < N_INC) { const int o = r / 1536, q = r % 1536, kb = q / 96, nb = q % 96, c0 = 32 * nb;
            const int drow = c0 < 1024 ? c0 : (c0 < 2048 ? 1024 + glu_row(c0 - 1024, 0) : 1024 + glu_row(c0 - 2048, 1));
            tr_item(A.in[18] + (size_t)o * DM * 3072, 3072, 64 * kb, c0, WINC + (size_t)o * 3072 * 1024, 1024, drow, scr, lane); continue; }
        r -= N_INC;
        { const int o = r / 512, q = r % 512, kb = q / 32, nb = q % 32;
            tr_item(A.in[20] + (size_t)o * DM * DM, DM, 64 * kb, 32 * nb, WOUTC + (size_t)o * DM * DM, DM, 32 * nb, scr, lane); }
    }
}

#undef A
__device__ __forceinline__ void prep2_phase(KArgs Ap, int lane, int wave) {
#define A (*Ap)
    const int gw = blockIdx.x * NWAVES + wave, NGW = gridDim.x * NWAVES;
    const float* mod = (const float*)(A.ws + WS_MOD); float* bias = (float*)(A.ws + WS_BIAS);
    constexpr int ROWS_L = 5632 + 3072 + 5632, ITEMS_L = ROWS_L / 32;
    for (int it = gw; it < 4 * ITEMS_L; it += NGW) {
        const int l = it / ITEMS_L, r32 = (it % ITEMS_L) * 32, e = l >> 1;
        int j, n0, N; const bf16* W;
        if (r32 < 5632) { j = 0; n0 = r32; N = 5632; W = (const bf16*)(A.ws + WS_WGU) + (size_t)(l * 2) * 5632 * 1024; }
        else if (r32 < 5632 + 3072) { j = 1; n0 = r32 - 5632; N = (l & 1) ? 3072 : 2048; if (n0 >= N) continue;
            W = (l & 1) ? (const bf16*)(A.ws + WS_WINC) + (size_t)e * 3072 * 1024 : (const bf16*)(A.ws + WS_WINAB) + (size_t)e * 2048 * 1024; }
        else { j = 2; n0 = r32 - 5632 - 3072; N = 5632; W = (const bf16*)(A.ws + WS_WGU) + (size_t)(l * 2 + 1) * 5632 * 1024; }
        const float* sh0 = mod + (size_t)(l * 2) * NMOD + (3 * j) * DM + 16 * lane; const float* sh1 = sh0 + NMOD;
        float s0[16], s1[16];
#pragma unroll
        for (int q = 0; q < 4; ++q) { const f32x4 a = ((const f32x4*)sh0)[q], b = ((const f32x4*)sh1)[q];
            s0[4 * q] = a.x; s0[4 * q + 1] = a.y; s0[4 * q + 2] = a.z; s0[4 * q + 3] = a.w; s1[4 * q] = b.x; s1[4 * q + 1] = b.y; s1[4 * q + 2] = b.z; s1[4 * q + 3] = b.w; }
        float* bo = bias + (size_t)l * BIAS_L + (j == 0 ? 0 : (j == 1 ? BIAS_MIX : BIAS_F2));
        for (int rr = 0; rr < 32; rr += 4) {
            u32x4 w0[4], w1[4];
#pragma unroll
            for (int u = 0; u < 4; ++u) { const u32x4* wp = (const u32x4*)(W + (size_t)(n0 + rr + u) * 1024 + 16 * lane); w0[u] = wp[0]; w1[u] = wp[1]; }
#pragma unroll
            for (int u = 0; u < 4; ++u) {
                const unsigned ww[8] = {w0[u].x, w0[u].y, w0[u].z, w0[u].w, w1[u].x, w1[u].y, w1[u].z, w1[u].w};
                float a0 = 0.f, a1 = 0.f;
#pragma unroll
                for (int q = 0; q < 8; ++q) { const float lo = bflo(ww[q]), hi = bfhi(ww[q]); a0 += s0[2 * q] * lo + s0[2 * q + 1] * hi; a1 += s1[2 * q] * lo + s1[2 * q + 1] * hi; }
                a0 = wave_sum(a0); a1 = wave_sum(a1);
                if (lane == 0) { bo[n0 + rr + u] = a0; bo[N + n0 + rr + u] = a1; }
            }
        }
    }
    const float* g = A.in[2]; bf16* xg = (bf16*)(A.ws + WS_H); float* rowss = (float*)(A.ws + WS_ROWSS);
    for (int m0 = gw; m0 < M; m0 += 4 * NGW) {
        f32x4 v[4][4];
#pragma unroll
        for (int k4 = 0; k4 < 4; ++k4) { const int m = (m0 + k4 * NGW < M) ? m0 + k4 * NGW : m0; const f32x4* xr = (const f32x4*)(A.in[0] + (size_t)m * DM) + lane;
#pragma unroll
            for (int j = 0; j < 4; ++j) v[k4][j] = xr[64 * j]; }
#pragma unroll
        for (int k4 = 0; k4 < 4; ++k4) { const int m = m0 + k4 * NGW; if (m >= M) break;
            const int b = m / SEQ; const float* sc = mod + (size_t)b * NMOD + DM;
            u32x2* o8 = (u32x2*)(xg + (size_t)m * DM) + lane; float s = 0.f;
#pragma unroll
            for (int j = 0; j < 4; ++j) { const f32x4 vv = v[k4][j]; s += (vv.x * vv.x + vv.y * vv.y) + (vv.z * vv.z + vv.w * vv.w);
                const f32x4 y = vv * ((const f32x4*)g)[lane + 64 * j] * (((const f32x4*)sc)[lane + 64 * j] + 1.0f);
                u32x2 w; w.x = pk2(y.x, y.y); w.y = pk2(y.z, y.w); o8[64 * j] = w; }
            s = wave_sum(s);
            if (lane < 16) rowss[(size_t)m * 16 + lane] = (lane == 0) ? s : 0.f; }
    }
}
#undef A
__device__ __forceinline__ void pool_phase(const bf16* proj  , bf16* mix, int lane, int wave) {
    const int gw = blockIdx.x * NWAVES + wave, NGW = gridDim.x * NWAVES;
    const int g = lane >> 4, w = 2 << g;
    for (int m = gw; m < M; m += NGW) {
        const int t = m % SEQ;
        const bf16* up = proj + (size_t)m * 2048 + 1536 + 8 * lane;
        const u32x4 c = *(const u32x4*)up;
        float s[8] = {bflo(c.x), bfhi(c.x), bflo(c.y), bfhi(c.y), bflo(c.z), bfhi(c.z), bflo(c.w), bfhi(c.w)};
        float cur[8];
#pragma unroll
        for (int e = 0; e < 8; ++e) cur[e] = s[e];
        const int cnt = (t + 1 < w) ? t + 1 : w;
        u32x4 pv[15];
#pragma unroll
        for (int j = 1; j < 16; ++j) { pv[j - 1] = (u32x4){0u, 0u, 0u, 0u}; if (j < cnt) pv[j - 1] = *(const u32x4*)(up - (size_t)j * 2048); }
#pragma unroll
        for (int j = 0; j < 15; ++j) { const u32x4 p = pv[j];
            s[0] += bflo(p.x); s[1] += bfhi(p.x); s[2] += bflo(p.y); s[3] += bfhi(p.y); s[4] += bflo(p.z); s[5] += bfhi(p.z); s[6] += bflo(p.w); s[7] += bfhi(p.w); }
        const float inv = 1.0f / (float)cnt;
        u32x4 o; o.x = pk2(s[0] * inv - cur[0], s[1] * inv - cur[1]); o.y = pk2(s[2] * inv - cur[2], s[3] * inv - cur[3]);
        o.z = pk2(s[4] * inv - cur[4], s[5] * inv - cur[5]); o.w = pk2(s[6] * inv - cur[6], s[7] * inv - cur[7]);
        *(u32x4*)(mix + (size_t)m * DM + 512 + 8 * lane) = o;
    }
}

__device__ __forceinline__ void conv_phase(const bf16* __restrict__ proj  , bf16* __restrict__ mix, const float* __restrict__ cw  , int tid) {
    const int gt = blockIdx.x * NTHR + tid, NGT = gridDim.x * NTHR;
    for (int i0 = gt; i0 < M * 128; i0 += 4 * NGT)
#pragma unroll
    for (int k4 = 0; k4 < 4; ++k4) { const int i = i0 + k4 * NGT; if (i >= M * 128) break;
        const int m = i >> 7, c8 = (i & 127) * 8, t = m % SEQ;
        const bf16* bp = proj + (size_t)m * 2048 + c8; const bf16* vp = bp + 1024;
        const u32x4 bb = *(const u32x4*)bp, v0 = *(const u32x4*)vp;
        u32x4 v1 = (u32x4){0u, 0u, 0u, 0u}, v2 = (u32x4){0u, 0u, 0u, 0u};
        if (t >= 1) v1 = *(const u32x4*)(vp - 2048);
        if (t >= 2) v2 = *(const u32x4*)(vp - 4096);
        const f32x4 w0a = *(const f32x4*)(cw + c8), w0b = *(const f32x4*)(cw + c8 + 4), w1a = *(const f32x4*)(cw + 1024 + c8), w1b = *(const f32x4*)(cw + 1024 + c8 + 4),
                    w2a = *(const f32x4*)(cw + 2048 + c8), w2b = *(const f32x4*)(cw + 2048 + c8 + 4);
        float y[8];
#define CV(e, W0, W1, W2, word, HI) y[e] = (HI ? bfhi(bb.word) : bflo(bb.word)) * (W0 * (HI ? bfhi(v2.word) : bflo(v2.word)) + W1 * (HI ? bfhi(v1.word) : bflo(v1.word)) + W2 * (HI ? bfhi(v0.word) : bflo(v0.word)))
        CV(0, w0a.x, w1a.x, w2a.x, x, 0); CV(1, w0a.y, w1a.y, w2a.y, x, 1); CV(2, w0a.z, w1a.z, w2a.z, y, 0); CV(3, w0a.w, w1a.w, w2a.w, y, 1);
        CV(4, w0b.x, w1b.x, w2b.x, z, 0); CV(5, w0b.y, w1b.y, w2b.y, z, 1); CV(6, w0b.z, w1b.z, w2b.z, w, 0); CV(7, w0b.w, w1b.w, w2b.w, w, 1);
#undef CV
        u32x4 o; o.x = pk2(y[0], y[1]); o.y = pk2(y[2], y[3]); o.z = pk2(y[4], y[5]); o.w = pk2(y[6], y[7]);
        *(u32x4*)(mix + (size_t)m * DM + c8) = o;
    }
}

__device__ __forceinline__ void qknorm_phase(const bf16* proj, bf16* qkn  , const float* qkg  , int lane, int wave) {
    const int gw = blockIdx.x * NWAVES + wave, NGW = gridDim.x * NWAVES;
    const int isk = lane >> 5;
    const float* g = qkg + isk * 64 + ((16 * lane) & 63);
    float gv[16];
#pragma unroll
    for (int q = 0; q < 4; ++q) { const f32x4 a = ((const f32x4*)g)[q]; gv[4 * q] = a.x; gv[4 * q + 1] = a.y; gv[4 * q + 2] = a.z; gv[4 * q + 3] = a.w; }
    const float qs = isk ? 1.0f : 0.125f * 1.4426950408889634f;
    for (int m = gw; m < M; m += NGW) {
        const u32x4* p = (const u32x4*)(proj + (size_t)m * 2048 + 16 * lane); u32x4* po = (u32x4*)(qkn + (size_t)m * 1024 + 16 * lane);
        const u32x4 w0 = p[0], w1 = p[1];
        const unsigned ww[8] = {w0.x, w0.y, w0.z, w0.w, w1.x, w1.y, w1.z, w1.w};
        float f[16], ss = 0.f;
#pragma unroll
        for (int q = 0; q < 8; ++q) { f[2 * q] = bflo(ww[q]); f[2 * q + 1] = bfhi(ww[q]); ss += f[2 * q] * f[2 * q] + f[2 * q + 1] * f[2 * q + 1]; }
        ss += __shfl_xor(ss, 1); ss += __shfl_xor(ss, 2);
        const float rstd = (1.0f / sqrtf(ss * (1.0f / 64.0f) + EPS)) * qs;
        u32x4 o0, o1;
        o0.x = pk2(f[0] * rstd * gv[0], f[1] * rstd * gv[1]); o0.y = pk2(f[2] * rstd * gv[2], f[3] * rstd * gv[3]); o0.z = pk2(f[4] * rstd * gv[4], f[5] * rstd * gv[5]); o0.w = pk2(f[6] * rstd * gv[6], f[7] * rstd * gv[7]);
        o1.x = pk2(f[8] * rstd * gv[8], f[9] * rstd * gv[9]); o1.y = pk2(f[10] * rstd * gv[10], f[11] * rstd * gv[11]); o1.z = pk2(f[12] * rstd * gv[12], f[13] * rstd * gv[13]); o1.w = pk2(f[14] * rstd * gv[14], f[15] * rstd * gv[15]);
        po[0] = o0; po[1] = o1;
    }
}

namespace att {
constexpr int STAGE = 32768, NSTAGE = 4, OFF_V = 16384, OFF_WS = 131072 + 1024;
__device__ __forceinline__ int crow(int i, int h) { return (i & 3) + 8 * (i >> 2) + 4 * h; }
__device__ __forceinline__ s16x4 vtr(const LAS unsigned char* p) { return __builtin_bit_cast(s16x4, __builtin_amdgcn_ds_read_tr16_b64_v4i16((LAS v4i16_t*)p)); }
#define MFMA32(a, b, c) __builtin_amdgcn_mfma_f32_32x32x16_bf16((a), (b), (c), 0, 0, 0)
__device__ __forceinline__ float max3f(float a, float b, float c) { float r; asm("v_max3_f32 %0, %1, %2, %3" : "=v"(r) : "v"(a), "v"(b), "v"(c)); return r; }
__device__ __forceinline__ float max2f(float a, float b) { float r; asm("v_max_f32_e32 %0, %1, %2" : "=v"(r) : "v"(a), "v"(b)); return r; }
__device__ __forceinline__ void glds16(const void* gsrc, unsigned lds_dst) { unsigned keep;
    asm volatile("s_mov_b32 %0, m0\n\ts_mov_b32 m0, %2\n\ts_nop 0\n\tglobal_load_lds_dwordx4 %1, off\n\ts_mov_b32 m0, %0" : "=&s"(keep) : "v"(gsrc), "s"(lds_dst) : "memory"); }
#define GLDS16(gp, lp) glds16((gp), (unsigned)__builtin_amdgcn_readfirstlane((int)(unsigned)(uintptr_t)(lp)))
__device__ __forceinline__ void glds16s(const void* sbase, unsigned voff, unsigned lds_dst) { unsigned keep;
    asm volatile("s_mov_b32 %0, m0\n\ts_mov_b32 m0, %3\n\ts_nop 0\n\tglobal_load_lds_dwordx4 %1, %2\n\ts_mov_b32 m0, %0" : "=&s"(keep) : "v"(voff), "s"(sbase), "s"(lds_dst) : "memory"); }
__device__ __forceinline__ void dma_tile(LAS unsigned char* st, const bf16* proj, const bf16* qkn, size_t rowbase, int hd, int t, int wid, unsigned koff, unsigned voff) {
    const unsigned ldsb = (unsigned)__builtin_amdgcn_readfirstlane((int)(unsigned)(uintptr_t)st);
    const char* kb = (const char*)(qkn + (rowbase + (size_t)(64 * t)) * 2048 + 512 + hd * 128 + 8 * wid);
    glds16s(kb, koff, ldsb + wid * 1024);
    glds16s(kb + 128, koff, ldsb + 8192 + wid * 1024);
#pragma unroll
    for (int i = 0; i < 2; ++i) { const int s = 2 * wid + i, db = s >> 2, kvg = s & 3;
        const char* vb = (const char*)(proj + (rowbase + (size_t)(64 * t + 16 * kvg)) * 2048 + 1024 + hd * 128 + 32 * db);
        glds16s(vb, voff, ldsb + OFF_V + s * 1024); }
}

template <bool MASKED> __device__ __forceinline__ void s_step(const LAS unsigned char* kb, const bf16x8 (&qr)[4], f32x16& negm, float& mref, f32x16 (&o)[4], float& lsum, bf16x8 (&pa)[4],
                                                            LAS float* wsf, int r, int h, int thr, bool first) {
    f32x16 p0, p1;
    bf16x8 ka[4], kc[4];
#pragma unroll
    for (int d0 = 0; d0 < 4; ++d0) { ka[d0] = *(const LAS bf16x8*)(kb + d0 * 2048); kc[d0] = *(const LAS bf16x8*)(kb + d0 * 2048 + 512); }
    __builtin_amdgcn_sched_barrier(0);
    __builtin_amdgcn_s_setprio(1);
    p0 = MFMA32(ka[0], qr[0], negm); p1 = MFMA32(kc[0], qr[0], negm);
#pragma unroll
    for (int d0 = 1; d0 < 4; ++d0) { p0 = MFMA32(ka[d0], qr[d0], p0); p1 = MFMA32(kc[d0], qr[d0], p1); }
    __builtin_amdgcn_s_setprio(0);
    if (MASKED) {
#pragma unroll
        for (int i = 0; i < 16; ++i) { const int kl = crow(i, h); if (kl > thr) p0[i] = -INFINITY; if (kl + 32 > thr) p1[i] = -INFINITY; } }
    asm volatile("s_nop 15\n\ts_nop 7" : "+v"(p0), "+v"(p1));
    float mx;
    { float a = max3f(p0[0], p0[1], p1[0]), c = max3f(p0[2], p0[3], p1[1]); a = max3f(a, p1[2], p1[3]);
#pragma unroll
      for (int i = 4; i < 16; i += 4) { a = max3f(a, p0[i], p0[i + 1]); c = max3f(c, p0[i + 2], p0[i + 3]); a = max3f(a, p1[i], p1[i + 1]); c = max3f(c, p1[i + 2], p1[i + 3]); }
      mx = max2f(a, c);
      const auto rr = __builtin_amdgcn_permlane32_swap(__float_as_uint(mx), __float_as_uint(mx), false, false);
      mx = max2f(__uint_as_float(rr[0]), __uint_as_float(rr[1])); }
    if (first || __any(mx > 8.0f)) {
        const float dl = first ? mx : fmaxf(mx, 0.f), alpha = __builtin_amdgcn_exp2f(-dl);
        mref += dl;
#pragma unroll
        for (int i = 0; i < 16; ++i) { p0[i] -= dl; p1[i] -= dl; negm[i] = -mref; }
        if (h == 0) wsf[r] = alpha;
        asm volatile("s_waitcnt lgkmcnt(0)" ::: "memory");
#pragma unroll
        for (int i = 0; i < 16; ++i) { const float a = wsf[crow(i, h)];
#pragma unroll
            for (int d = 0; d < 4; ++d) o[d][i] *= a; }
        lsum *= alpha;
    }
    float ps0 = 0.f, ps1 = 0.f;
#pragma unroll
    for (int i = 0; i < 16; ++i) { p0[i] = __builtin_amdgcn_exp2f(p0[i]); p1[i] = __builtin_amdgcn_exp2f(p1[i]); ps0 += p0[i]; ps1 += p1[i]; }
    lsum += ps0 + ps1;
    u32x4 w;
    w.x = pk2(p0[0], p0[1]); w.y = pk2(p0[2], p0[3]); w.z = pk2(p0[4], p0[5]); w.w = pk2(p0[6], p0[7]); pa[0] = __builtin_bit_cast(bf16x8, w);
    w.x = pk2(p0[8], p0[9]); w.y = pk2(p0[10], p0[11]); w.z = pk2(p0[12], p0[13]); w.w = pk2(p0[14], p0[15]); pa[1] = __builtin_bit_cast(bf16x8, w);
    w.x = pk2(p1[0], p1[1]); w.y = pk2(p1[2], p1[3]); w.z = pk2(p1[4], p1[5]); w.w = pk2(p1[6], p1[7]); pa[2] = __builtin_bit_cast(bf16x8, w);
    w.x = pk2(p1[8], p1[9]); w.y = pk2(p1[10], p1[11]); w.z = pk2(p1[12], p1[13]); w.w = pk2(p1[14], p1[15]); pa[3] = __builtin_bit_cast(bf16x8, w);
}
__device__ __forceinline__ void pv_step(const LAS unsigned char* vb, const bf16x8 (&pa)[4], f32x16 (&o)[4]) {
    s16x4 vlo[4][4], vhi[4][4];
#pragma unroll
    for (int db = 0; db < 4; ++db)
#pragma unroll
        for (int s = 0; s < 4; ++s) { vlo[db][s] = vtr(vb + (db * 4 + s) * 1024); vhi[db][s] = vtr(vb + (db * 4 + s) * 1024 + 512); }
    __builtin_amdgcn_sched_barrier(0);
    __builtin_amdgcn_s_setprio(1);
#pragma unroll
    for (int db = 0; db < 4; ++db)
#pragma unroll
        for (int s = 0; s < 4; ++s) { const bf16x8 vf = __builtin_shufflevector(vlo[db][s], vhi[db][s], 0, 1, 2, 3, 4, 5, 6, 7);
            o[db] = MFMA32(pa[s], vf, o[db]); }
    __builtin_amdgcn_s_setprio(0);
}

template <int MODE  > __device__ __forceinline__ void attn_unit(LAS unsigned char* lds, const bf16* proj, const bf16* qkn, bf16* mix, int b, int hd, int qb, const float* subg  , float lam, float oscale, int tid) {
    const int lane = tid & 63, r = lane & 31, h = lane >> 5; const int wid = __builtin_amdgcn_readfirstlane(tid >> 6);
    const int sub = wid >> 2, wq = wid & 3;
    const size_t rowbase = (size_t)b * SEQ; const int q0 = qb * 128, qw = q0 + wq * 32;
    const int NT = 2 * qb + 2, ntw = (qw >> 6) + 1;
    LAS float* wsf = (LAS float*)(lds + OFF_WS) + wid * 64;
    const unsigned dkoff = (unsigned)lane * 4096u, dvoff = (unsigned)(lane >> 2) * 4096u + (unsigned)(lane & 3) * 16u;
#pragma unroll
    for (int j = 0; j < NSTAGE; ++j) if (j < NT) dma_tile(lds + j * STAGE, proj, qkn, rowbase, hd, j, wid, dkoff, dvoff);
    bf16x8 qr[4];
    { const bf16* qp = qkn + (rowbase + (size_t)(qw + r)) * 2048 + hd * 128 + sub * 64 + 8 * h;
#pragma unroll
      for (int d0 = 0; d0 < 4; ++d0) qr[d0] = *(const bf16x8*)(qp + 16 * d0); }
    f32x16 o[4], negm;
#pragma unroll
    for (int i = 0; i < 16; ++i) { o[0][i] = 0.f; o[1][i] = 0.f; o[2][i] = 0.f; o[3][i] = 0.f; negm[i] = 0.f; }
    float mref = 0.f, lsum = 0.f;
    bf16x8 pa[4];
#pragma unroll
    for (int s = 0; s < 4; ++s) pa[s] = (bf16x8){0, 0, 0, 0, 0, 0, 0, 0};
    const int vlane = (4 * h + ((lane & 15) >> 2)) * 64 + ((lane >> 4) & 1) * 32 + (lane & 3) * 8;
    const LAS unsigned char* kbase = lds + sub * 8192 + h * 1024 + r * 16;
    const LAS unsigned char* vbase = lds + OFF_V + vlane;
    asm volatile("s_waitcnt vmcnt(0)" ::: "memory");
    asm volatile("" : "+v"(qr[0]), "+v"(qr[1]), "+v"(qr[2]), "+v"(qr[3]));
    __builtin_amdgcn_s_barrier();
#define STEP_BEGIN(t_) do { const int k_ = (t_) + 2; if ((t_) >= 2 && k_ < NT) dma_tile(lds + (k_ & 3) * STAGE, proj, qkn, rowbase, hd, k_, wid, dkoff, dvoff); } while (0)
#define STEP_END(t_) do { if ((t_) >= 2 && (t_) + 2 < NT) asm volatile("s_waitcnt vmcnt(4)" ::: "memory"); else asm volatile("s_waitcnt vmcnt(0)" ::: "memory"); \
        asm volatile("s_waitcnt lgkmcnt(0)" ::: "memory"); __builtin_amdgcn_s_barrier(); } while (0)
#define KB(t_) (kbase + ((t_) & 3) * STAGE)
#define VB(t_) (vbase + ((t_) & 3) * STAGE)
    if (sub == 0) {
        int t = 0;
        for (; t < ntw - 1; ++t) { STEP_BEGIN(t); s_step<false>(KB(t), qr, negm, mref, o, lsum, pa, wsf, r, h, 0, t == 0); pv_step(VB(t), pa, o); STEP_END(t); }
        { STEP_BEGIN(t); s_step<true>(KB(t), qr, negm, mref, o, lsum, pa, wsf, r, h, qw + r - 64 * t, t == 0); pv_step(VB(t), pa, o); STEP_END(t); ++t; }
        for (; t < NT; ++t) { STEP_BEGIN(t); STEP_END(t); }
        asm volatile("s_waitcnt lgkmcnt(0)" ::: "memory"); __builtin_amdgcn_s_barrier();
    } else {
        int t = 0;
        { STEP_BEGIN(0); if (ntw > 1) s_step<false>(KB(0), qr, negm, mref, o, lsum, pa, wsf, r, h, 0, true); else s_step<true>(KB(0), qr, negm, mref, o, lsum, pa, wsf, r, h, qw + r, true); STEP_END(0); t = 1; }
        for (; t < ntw - 1; ++t) { STEP_BEGIN(t); pv_step(VB(t - 1), pa, o); s_step<false>(KB(t), qr, negm, mref, o, lsum, pa, wsf, r, h, 0, false); STEP_END(t); }
        if (t < ntw) { STEP_BEGIN(t); pv_step(VB(t - 1), pa, o); s_step<true>(KB(t), qr, negm, mref, o, lsum, pa, wsf, r, h, qw + r - 64 * t, false); STEP_END(t); ++t; }
        if (t < NT) { STEP_BEGIN(t); pv_step(VB(t - 1), pa, o); STEP_END(t); ++t; for (; t < NT; ++t) { STEP_BEGIN(t); STEP_END(t); } }
        else pv_step(VB(t - 1), pa, o);
        asm volatile("s_waitcnt lgkmcnt(0)" ::: "memory"); __builtin_amdgcn_s_barrier();
    }
#undef STEP_BEGIN
#undef STEP_END
#undef KB
#undef VB
    int lane_f = lane; asm volatile("" : "+v"(lane_f));
    const int r_f = lane_f & 31, h_f = lane_f >> 5;
    { const auto rr = __builtin_amdgcn_permlane32_swap(__float_as_uint(lsum), __float_as_uint(lsum), false, false); lsum = __uint_as_float(rr[0]) + __uint_as_float(rr[1]); }
    if (h_f == 0) wsf[r_f] = (sub ? lam : 1.0f) / lsum;
    asm volatile("s_waitcnt lgkmcnt(0)" ::: "memory");
#pragma unroll
    for (int i = 0; i < 16; ++i) { const float a = wsf[crow(i, h_f)];
#pragma unroll
        for (int d = 0; d < 4; ++d) o[d][i] *= a; }
    LAS float* xo = (LAS float*)(lds + wq * 16384);
    if (sub == 1) {
#pragma unroll
        for (int d = 0; d < 4; ++d)
#pragma unroll
            for (int i = 0; i < 16; ++i) xo[crow(i, h_f) * 128 + 32 * d + r_f] = o[d][i];
    }
    __syncthreads();
    if (sub == 0) {
#pragma unroll
        for (int d = 0; d < 4; ++d)
#pragma unroll
            for (int i = 0; i < 16; ++i) { const int a = crow(i, h_f) * 128 + 32 * d + r_f; xo[a] = o[d][i] - xo[a]; }
    }
    __syncthreads();
    if (sub == 0) {
        const int row = lane_f >> 1, half = lane_f & 1;
        const LAS f32x4* src = (const LAS f32x4*)(xo + row * 128 + half * 64);
        f32x4 v[16]; float ss = 0.f;
#pragma unroll
        for (int j = 0; j < 16; ++j) { v[j] = src[j]; ss += (v[j].x * v[j].x + v[j].y * v[j].y) + (v[j].z * v[j].z + v[j].w * v[j].w); }
        ss += __shfl_xor(ss, 1);
        const float rstd = (1.0f / sqrtf(ss * (1.0f / 128.0f) + EPS)) * oscale;
        bf16* dst = mix + (rowbase + (size_t)(qw + row)) * DM + hd * 128 + half * 64;
        const f32x4* gs = (const f32x4*)(subg + half * 64);
#pragma unroll
        for (int j = 0; j < 8; ++j) { const f32x4 a = v[2 * j] * rstd * gs[2 * j], c = v[2 * j + 1] * rstd * gs[2 * j + 1];
            u32x4 w; w.x = pk2(a.x, a.y); w.y = pk2(a.z, a.w); w.z = pk2(c.x, c.y); w.w = pk2(c.z, c.w); *(u32x4*)(dst + 8 * j) = w; }
    }
    __syncthreads();
}
}

typedef unsigned v4u __attribute__((ext_vector_type(4)));
#define XB_TMO      128
#define XB_XCNT(j)  (256  + 64 * (j))
#define XB_XSUB(j)  (1280 + 64 * (j))
#define XB_XGEN(j)  (2304 + 64 * (j))
#define XB_TOP      3328
#define XB_TOPGEN   3392
#define XCD_BAR_WORDS 3456
#define XB_SPIN_CAP (1u << 18)

__device__ __forceinline__ unsigned xb_ld(unsigned* p)              { return __hip_atomic_load(p, __ATOMIC_RELAXED, __HIP_MEMORY_SCOPE_AGENT); }
__device__ __forceinline__ unsigned xb_add(unsigned* p, unsigned v) { return __hip_atomic_fetch_add(p, v, __ATOMIC_RELAXED, __HIP_MEMORY_SCOPE_AGENT); }
__device__ __forceinline__ unsigned xb_xcc_id() { return (unsigned)__builtin_amdgcn_s_getreg((3 << 11) | 20) & 0xFu; }
#define XB_SPIN(cond, bar) do { unsigned _sp = 0; while (cond) { __builtin_amdgcn_s_sleep(1); \
    if ((++_sp & 255u) == 0u) { if (xb_ld(&(bar)[XB_TMO])) break; if (_sp > XB_SPIN_CAP) { atomicAdd(&(bar)[XB_TMO], 1u); break; } } } } while (0)

struct XcdBarrier {
    unsigned* bar; unsigned x;
    volatile LAS unsigned* st;
};

__device__ __forceinline__ XcdBarrier xcd_barrier_post(unsigned* bar, volatile LAS unsigned* st) {
    XcdBarrier b; b.bar = bar; b.x = xb_xcc_id(); b.st = st;
    if (threadIdx.x == 0) (void)xb_add(&bar[XB_XCNT(b.x)], 1u);
    return b;
}
__device__ __forceinline__ void xcd_barrier_complete(unsigned* bar, unsigned x, unsigned& nloc, unsigned& nx) {
    const unsigned G = gridDim.x * gridDim.y * gridDim.z;
    unsigned sum, cnt, mine, sp = 0u;
    for (;;) {
        sum = 0u; cnt = 0u; mine = 0u;
#pragma unroll
        for (unsigned j = 0; j < 16; ++j) { const unsigned c = xb_ld(&bar[XB_XCNT(j)]); sum += c; cnt += (c > 0u) ? 1u : 0u; mine = (j == x) ? c : mine; }
        if (sum == G) break;
        __builtin_amdgcn_s_sleep(1);
        if ((++sp & 255u) == 0u) { if (xb_ld(&bar[XB_TMO])) break; if (sp > XB_SPIN_CAP) { atomicAdd(&bar[XB_TMO], 1u); break; } }
    }
    nloc = mine > 0u ? mine : 1u; nx = cnt > 0u ? cnt : 1u;
}

__device__ __forceinline__ void xcd_barrier(const XcdBarrier& b, const bool lead  ) {
    asm volatile("s_waitcnt vmcnt(0)" ::: "memory");
    __syncthreads();
    if (lead) {
        unsigned* bar = b.bar;
        __builtin_amdgcn_s_waitcnt(0);
        unsigned nloc = b.st[0], nx = b.st[1];
        if (nloc == 0u) { xcd_barrier_complete(bar, b.x, nloc, nx); b.st[0] = nloc; b.st[1] = nx; }
        const unsigned old = xb_add(&bar[XB_XSUB(b.x)], 1u);
        const unsigned gen = old / nloc;
        if (old + 1u == (gen + 1u) * nloc) {
            __builtin_amdgcn_fence(__ATOMIC_RELEASE, "agent");
            asm volatile("s_waitcnt vmcnt(0)" ::: "memory");
            const unsigned og = xb_add(&bar[XB_TOP], 1u);
            const unsigned tg = og / nx;
            if (og + 1u == (tg + 1u) * nx) xb_add(&bar[XB_TOPGEN], 1u);
            else XB_SPIN(xb_ld(&bar[XB_TOPGEN]) == tg, bar);
            __builtin_amdgcn_fence(__ATOMIC_ACQUIRE, "agent");
            xb_add(&bar[XB_XGEN(b.x)], 1u);
            asm volatile("s_waitcnt vmcnt(0)" ::: "memory");
        } else {
            XB_SPIN(xb_ld(&bar[XB_XGEN(b.x)]) == gen, bar);
            __builtin_amdgcn_fence(__ATOMIC_ACQUIRE, "agent");
            asm volatile("s_waitcnt vmcnt(0)" ::: "memory");
        }
    }
    __syncthreads();
}

#define XL_RANK(j) (3520 + 64 * (j))
#define XL_SUB(j)  (4608 + 64 * (j))
#define XL_GEN(j)  (5696 + 64 * (j))
constexpr int CTL_ZERO_BYTES = 32768;
__device__ __forceinline__ void xcd_local_barrier(unsigned* bar, unsigned x, unsigned nloc, const bool lead, volatile LAS unsigned* genw  ) {
    asm volatile("s_waitcnt vmcnt(0)" ::: "memory");
    __syncthreads();
    if (lead) {
        __builtin_amdgcn_s_waitcnt(0);
        const unsigned gen = genw[0]; genw[0] = gen + 1u;
        const unsigned old = xb_add(&bar[XL_SUB(x)], 1u);
        if (old + 1u == (gen + 1u) * nloc) xb_add(&bar[XL_GEN(x)], 1u);
        else XB_SPIN(xb_ld(&bar[XL_GEN(x)]) == gen, bar);
        __builtin_amdgcn_fence(__ATOMIC_ACQUIRE, "agent");
        asm volatile("s_waitcnt vmcnt(0)" ::: "memory");
    }
    __syncthreads();
}

__global__ void __launch_bounds__(NTHR, 2) fwd_kernel(Args A_by_value) {
    KArgs Ap0 = (KArgs)__builtin_amdgcn_kernarg_segment_ptr();
#define A (*Ap)
    KArgs Ap = Ap0;
    extern __shared__ __attribute__((aligned(16))) unsigned char lds_raw[];
    LAS unsigned char* lds = (LAS unsigned char*)lds_raw;
    cg::grid_group grid = cg::this_grid();
    const int wave0 = __builtin_amdgcn_readfirstlane((int)threadIdx.x >> 6);
    volatile LAS unsigned* MISC = (volatile LAS unsigned*)(lds + 131072);
    if (threadIdx.x < 64) MISC[threadIdx.x] = 0u;
    __syncthreads();
    const XcdBarrier bar = xcd_barrier_post((unsigned*)A.ws, MISC + 8);
    if (threadIdx.x == 0) { MISC[16] = xb_add(&((unsigned*)A.ws)[XL_RANK(bar.x)], 1u); MISC[17] = 0u; MISC[18] = 0u; }
    __syncthreads();
    int ph = A.ph_lo, rep = 0;
    while (ph < A.ph_hi) {
#if PROBE
        int ptype; if (ph == 0) ptype = 0; else if (ph == 1) ptype = 1; else { const int s_ = (ph - 2) % 7, l_ = (ph - 2) / 7; ptype = (s_ == 0 || s_ == 5) ? 2 : (s_ == 2 ? 3 : ((s_ == 1 || s_ == 6) ? 4 : (s_ == 4 ? 5 : ((l_ & 1) ? 7 : 9)))); }
        const int nrep = 1 + ((PROBE >> ptype) & 1);
#else
        const int nrep = 1;
#endif
        Ap = Ap0; asm volatile("" : "+s"(Ap));
#define tid fresh_tid(wave0)
#define lane (fresh_tid(wave0) & 63)
#define wave wave0
        const int G = gridDim.x;
        if (ph >= 2 && (unsigned)__builtin_amdgcn_readfirstlane((int)MISC[17]) == 0u) {
            if (fresh_tid(wave0) == 0) { unsigned ok = (G % 8 == 0) ? 1u : 0u;
                for (unsigned j = 0; j < 16; ++j) { const unsigned c = xb_ld(&((unsigned*)A.ws)[XL_RANK(j)]); if (c != (j < 8 ? (unsigned)G >> 3 : 0u)) ok = 0u; }
                MISC[17] = ok ? 1u : 2u; }
            __syncthreads();
        }
        const bool teamed = (ph >= 2) && (unsigned)__builtin_amdgcn_readfirstlane((int)MISC[17]) == 1u;
        const int vc = teamed ? (int)((unsigned)__builtin_amdgcn_readfirstlane((int)MISC[16]) * 8u + bar.x) : (int)blockIdx.x;
        unsigned char* ws = A.ws; asm volatile("" : "+s"(ws));
        float* const mod = (float*)(ws + WS_MOD);
        bf16* const Hb = (bf16*)(ws + WS_H); bf16* const MIXb = (bf16*)(ws + WS_MIX); bf16* const ACTb = (bf16*)(ws + WS_ACT);
        float* const rowss = (float*)(ws + WS_ROWSS);
        if (ph == 0) { prep_phase(Ap, lds, tid, lane, wave); }
        else if (ph == 1) { prep2_phase(Ap, lane, wave); }
        else {
            const int l = (ph - 2) / 7, s = (ph - 2) % 7, e = l >> 1;
            const float* modl = mod + (size_t)l * 2 * NMOD;
            const float* xcur = (ph <= 3) ? A.in[0] : A.out;
            const float* biasl = (const float*)(ws + WS_BIAS) + (size_t)l * BIAS_L;
            if (s == 0 || s == 5 || s == 2) {
                const bf16* W; int N, ldc, pn0, colbase, act, qkn = 0; const float* bias;
                if (s != 2) { W = (const bf16*)(ws + WS_WGU) + (size_t)(l * 2 + (s == 0 ? 0 : 1)) * 5632 * 1024; N = 5632; ldc = FF; pn0 = 0; colbase = 0; act = 1; bias = biasl + (s == 0 ? 0 : BIAS_F2); }
                else if ((l & 1) == 0) { W = (const bf16*)(ws + WS_WINAB) + (size_t)e * 2048 * 1024; N = 2048; ldc = 2048; pn0 = 8; colbase = 0; act = 0; bias = biasl + BIAS_MIX; qkn = 1; }
                else { W = (const bf16*)(ws + WS_WINC) + (size_t)e * 3072 * 1024; N = 3072; ldc = 2048; pn0 = 4; colbase = 1024; act = 0; bias = biasl + BIAS_MIX; }
                pg8::Gemm g{Hb, W, M, N, DM, (PROBE_BLIN && rep + 1 < nrep) ? 1 : 0}; pg8::StaticOrder S; S.init(M, N, G, vc);
                LAS unsigned* EP = (LAS unsigned*)(lds + 131072 + 256);
                if (tid == 0) pg8::EpiMix::put(EP, ACTb, ldc, pn0, colbase, act, rowss, bias, N, qkn, A.in[9] + e * 128);
                { LAS float* BC = (LAS float*)(lds + 131072 + (qkn ? 1024 : 4096)); pg8::Unit uu; const int t_ = tid;
                  for (int i = 0; S.next(i, uu); ++i) if (t_ < 256) BC[i * 256 + t_] = bias[(size_t)((uu.pm * 256) / SEQ) * N + uu.pn * 256 + t_]; }
                __syncthreads();
                pg8::EpiMix E{EP};
                pg8::gemm_phase<pg8::EpiMix, pg8::StaticOrder, true, true>(lds, g, S, E, tid);
            } else if (s == 1 || s == 6 || s == 4) {
                const bf16* Ain; const bf16* W; int K; const float* gate; float gs;
                if (s != 4) { Ain = ACTb; W = (const bf16*)(ws + WS_WD) + (size_t)(l * 2 + (s == 1 ? 0 : 1)) * 1024 * FF; K = FF; gate = modl + (s == 1 ? 2 : 8) * DM; gs = 0.5f; }
                else { Ain = MIXb; W = ((l & 1) == 0 ? (const bf16*)(ws + WS_WOUTAB) : (const bf16*)(ws + WS_WOUTC)) + (size_t)e * DM * DM; K = DM; gate = modl + 5 * DM; gs = 1.0f; }
                const int nl = (s == 6) ? l + 1 : l, nj = (s == 1) ? 1 : (s == 4 ? 2 : 0);
                const int has_nxt = nl < 4, nlc = has_nxt ? nl : 3;
                const float* ng = A.in[2] + (size_t)(nlc * 3 + nj) * DM;
                const float* nsc = mod + (size_t)nlc * 2 * NMOD + (3 * nj + 1) * DM;
                pg8::Gemm g{Ain, W, M, DM, K, 0}; pg8::StaticOrder S; S.init(M, DM, G, vc);
                LAS unsigned* EP = (LAS unsigned*)(lds + 131072 + 256);
                if (tid == 0) pg8::EpiRes::put(EP, xcur, A.out, gate, (rep + 1 < nrep) ? 0.0f : gs, ng, nsc, Hb, rowss, has_nxt);
                __syncthreads();
                pg8::EpiRes E{EP};
                pg8::gemm_phase<pg8::EpiRes, pg8::StaticOrder, true, true>(lds, g, S, E, tid);
            } else {
                if ((l & 1) == 0) {
                    for (int rp = 0; rp < 1 + ((PROBE >> 6) & 1); ++rp) pool_phase(ACTb, MIXb, lane, wave);
                    const float* lq1 = A.in[10] + e * 64; const float* lk1 = A.in[11] + e * 64; const float* lq2 = A.in[12] + e * 64; const float* lk2 = A.in[13] + e * 64;
                    float s1 = 0.f, s2 = 0.f;
                    for (int i = 0; i < 64; ++i) { s1 += lq1[i] * lk1[i]; s2 += lq2[i] * lk2[i]; }
                    const float lam_init = 0.8f - 0.6f * expf(-0.3f * (float)l);
                    const float lam = expf(s1) - expf(s2) + lam_init;
                    for (int ui = 0; ui < 2; ++ui) {
                        for (int v0 = vc; v0 < 256; v0 += G) {
                            const int v = (G == 256) ? (v0 & 7) * 32 + (v0 >> 3) : v0;
                            const int bh = v >> 5, x = v & 31, qb = ui == 0 ? 63 - x : x;
#if PROBE_ATT
                            att::attn_unit<PROBE_ATT>(lds, ACTb, ACTb, MIXb, bh >> 2, bh & 3, qb, A.in[14] + e * 128, lam, 1.0f - lam_init, tid);
#endif
                            att::attn_unit<0>(lds, ACTb, ACTb, MIXb, bh >> 2, bh & 3, qb, A.in[14] + e * 128, lam, 1.0f - lam_init, tid);
                        }
                    }
                } else conv_phase(ACTb, MIXb, A.in[19] + (size_t)e * 3 * DM, tid);
            }
        }
        if (ph + 1 < A.ph_hi || rep + 1 < nrep) {
            const int s_ = (ph >= 2) ? (ph - 2) % 7 : -1;
            if (A.ph_hi > 1000000) grid.sync();
            else if (teamed && !PROBE && (s_ == 0 || s_ == 1 || s_ == 4 || s_ == 5 || s_ == 6)) xcd_local_barrier(bar.bar, bar.x, (unsigned)G >> 3, fresh_tid(wave0) == 0, MISC + 18);
            else xcd_barrier(bar, fresh_tid(wave0) == 0);
        }
        if (rep + 1 < nrep) ++rep; else { rep = 0; ++ph; }
    }
}

#ifndef PROBE
#define PROBE 0
#endif
#undef tid
#undef lane
#undef wave
#undef A
#ifndef N_LAUNCH_MODE
#define N_LAUNCH_MODE 1
#endif
extern "C" void kernel_launch(void* const* d_in, const int* in_sizes, int n_in, void* d_out, int out_size, void* d_ws, size_t ws_size, hipStream_t stream) {
    static int grid = 0;
    if (grid == 0) {
        if (n_in != 21 || out_size != M * DM || ws_size < WS_END) { fprintf(stderr, "kernel_launch: unexpected problem (n_in %d out %d ws %zu)\n", n_in, out_size, ws_size); grid = -1; return; }
        int dev = 0, cus = 0, per_cu = 0;
        hipGetDevice(&dev); hipDeviceGetAttribute(&cus, hipDeviceAttributeMultiprocessorCount, dev);
        if (hipFuncSetAttribute((const void*)fwd_kernel, hipFuncAttributeMaxDynamicSharedMemorySize, LDS_BYTES) != hipSuccess) { fprintf(stderr, "kernel_launch: hipFuncSetAttribute failed\n"); grid = -1; return; }
        if (hipOccupancyMaxActiveBlocksPerMultiprocessor(&per_cu, (const void*)fwd_kernel, NTHR, LDS_BYTES) != hipSuccess || per_cu < 1) { fprintf(stderr, "kernel_launch: occupancy query says %d\n", per_cu); per_cu = 1; }
        (void)hipGetLastError();
        grid = cus * 1;
    }
    if (grid < 0) return;
    if (hipMemsetAsync(d_ws, 0, CTL_ZERO_BYTES, stream) != hipSuccess) { fprintf(stderr, "kernel_launch: memset of the barrier words failed\n"); return; }
    Args a{};
    for (int i = 0; i < 21; ++i) a.in[i] = (const float*)d_in[i];
    a.out = (float*)d_out; a.ws = (unsigned char*)d_ws;
    constexpr int NPH = 30;
#if N_LAUNCH_MODE == 0
    for (int ph = 0; ph < NPH; ++ph) { a.ph_lo = ph; a.ph_hi = ph + 1; hipLaunchKernelGGL(fwd_kernel, dim3(grid), dim3(NTHR), LDS_BYTES, stream, a); }
#else
    a.ph_lo = 0; a.ph_hi = NPH;
    void* args[] = {&a};
    hipError_t e = hipLaunchCooperativeKernel((const void*)fwd_kernel, dim3(grid), dim3(NTHR), args, LDS_BYTES, stream);
    if (e != hipSuccess) fprintf(stderr, "cooperative launch failed: %s (grid %d)\n", hipGetErrorString(e), grid);
#endif
}
```

```cpp
#include <hip/hip_runtime.h>
#include <hip/hip_cooperative_groups.h>
#include <cstdio>
#include <cstdint>
namespace cg = cooperative_groups;
namespace pg8 {
#define PG8_LAS __attribute__((address_space(3)))
typedef unsigned short bf16_t;
typedef short bf16x8 __attribute__((ext_vector_type(8)));
typedef float f32x4 __attribute__((ext_vector_type(4)));
typedef unsigned u32x4 __attribute__((ext_vector_type(4)));
constexpr int BM = 256, BK = 64, HALF = 128, HTB = HALF * BK * 2  , STAGE_BYTES = 8 * HTB, NXCD = 8, WGM = 8;

__host__ __device__ __forceinline__ int lds_byte(int r, int c) { const int st = (r >> 4) * 2 + (c >> 5), rr = r & 15, cc = c & 31, ob = rr * 64 + cc * 2; return st * 1024 + (ob ^ (((ob >> 9) & 1) << 5)); }
__host__ __device__ __forceinline__ void stage_rc(int b, int& R, int& C) { const int st = b / 1024, sb = b % 1024, swz = sb ^ (((sb >> 9) & 1) << 5); R = (st >> 1) * 16 + swz / 64; C = (st & 1) * 32 + (swz % 64) / 2; }
__host__ __device__ __forceinline__ int perm32(int rho) { const int n = rho >> 4, i = rho & 15; return 8 * (i >> 2) + 4 * n + (i & 3); }

struct Unit { int pm, pn, half, narrow, idx; };
struct Gemm { const bf16_t* A; const bf16_t* Bt; int M, N, K; int blin; };

struct StaticOrder {
    int nM, nN, nwg, G, c, nfull, tail;
    __host__ __device__ void init(int M, int N, int G_, int c_) { nM = M / BM; nN = N / BM; nwg = nM * nN; G = G_; c = c_; nfull = nwg / G; tail = ((nwg % G) * 2 == G && (G % 16) == 0) ? 1 : 0; }
    __host__ __device__ bool next(int i, Unit& u) const {
        long L = (long)i * G + c; u.half = 0; u.narrow = 0; u.idx = i;
        if (tail && i >= nfull) { if (i > nfull) return false; const int x = c % NXCD, li = c / NXCD; L = (long)nfull * G + (li >> 1) * NXCD + x; u.half = li & 1; u.narrow = 1; }
        if (L >= nwg) return false;
        int wgid = (int)L; { const int q = nwg / NXCD, r = nwg % NXCD, xcd = wgid % NXCD, off = wgid / NXCD; wgid = (xcd < r ? xcd * (q + 1) : r * (q + 1) + (xcd - r) * q) + off; }
        const int nig = WGM * nN, gid = wgid / nig, fm = gid * WGM, gsz = (nM - fm) < WGM ? (nM - fm) : WGM;
        u.pm = fm + ((wgid % nig) % gsz); u.pn = (wgid % nig) / gsz; return true;
    }
    __device__ __forceinline__ void a_ready(const Unit&) const {}
    __device__ __forceinline__ void done(const Unit&) const {}
};

typedef float f32x2 __attribute__((ext_vector_type(2)));
typedef __bf16 bf16x2_t __attribute__((ext_vector_type(2)));
__device__ __forceinline__ unsigned cvt_pk_bf16(float lo, float hi) { f32x2 v = {lo, hi}; bf16x2_t b = __builtin_convertvector(v, bf16x2_t); return __builtin_bit_cast(unsigned, b); }
__device__ __forceinline__ float silu_f(float v) { return v * __builtin_amdgcn_rcpf(1.0f + __builtin_amdgcn_exp2f(-1.4426950408889634f * v)); }

#define PG8_GAS __attribute__((address_space(1)))
template <class T> __device__ __forceinline__ T* lds_ptr(const PG8_LAS unsigned* q) { const unsigned lo = __builtin_amdgcn_readfirstlane(q[0]), hi = __builtin_amdgcn_readfirstlane(q[1]); return (T*)(((unsigned long long)hi << 32) | lo); }
__device__ __forceinline__ int lds_int(const PG8_LAS unsigned* q) { return (int)__builtin_amdgcn_readfirstlane(q[0]); }
__device__ __forceinline__ void lds_put(PG8_LAS unsigned* q, const void* p) { const unsigned long long v = (unsigned long long)p; q[0] = (unsigned)v; q[1] = (unsigned)(v >> 32); }
struct EpiMix {
    static constexpr bool PERM = true, AFTER_DRAIN = false;
    const PG8_LAS unsigned* P;
    static __device__ __forceinline__ void put(PG8_LAS unsigned* P, bf16_t* O, int ldc, int pn0, int colbase, int act, const float* rowss, const float* bias, int N, int qkn, const float* qkg) {
        lds_put(P, O); lds_put(P + 2, rowss); lds_put(P + 4, bias); P[6] = ldc; P[7] = pn0; P[8] = colbase; P[9] = act; P[10] = N; P[11] = qkn; lds_put(P + 12, qkg); P[14] = 0xFFFFFFFFu; }
    __device__ __forceinline__ void operator()(const f32x4 (&acc)[2][2][4][2], const Unit& u, int wr, int wc, int fr, int fq) const {
        PG8_GAS bf16_t* const O = (PG8_GAS bf16_t*)lds_ptr<bf16_t>(P); const PG8_GAS float* const rowss = (const PG8_GAS float*)lds_ptr<const float>(P + 2); const PG8_GAS float* const bias = (const PG8_GAS float*)lds_ptr<const float>(P + 4);
        const int ldc = lds_int(P + 6), pn0 = lds_int(P + 7), colbase = lds_int(P + 8), act_silu = lds_int(P + 9), N = lds_int(P + 10);
        const int row0 = u.pm * BM + u.half * HALF + wr * 64 + fr; const int nai = u.narrow ? 1 : 2;
        PG8_LAS float* RS = (PG8_LAS float*)((PG8_LAS unsigned char*)P - 256 + 12288);
        if (lds_int(P + 14) != u.pm) {
            const int t = (wr * 4 + wc) * 64 + fq * 16 + fr;
            if (t < 256) { const PG8_GAS f32x4* sp = (const PG8_GAS f32x4*)(rowss + (size_t)(u.pm * BM + t) * 16);
                const f32x4 a = sp[0], b = sp[1], c = sp[2], d = sp[3];
                const float ss = ((a[0] + a[1]) + (a[2] + a[3])) + ((b[0] + b[1]) + (b[2] + b[3])) + ((c[0] + c[1]) + (c[2] + c[3])) + ((d[0] + d[1]) + (d[2] + d[3]));
                RS[t] = 1.0f / sqrtf(ss * (1.0f / 1024.0f) + 1e-6f); }
            asm volatile("s_waitcnt lgkmcnt(0)" ::: "memory"); __builtin_amdgcn_s_barrier(); asm volatile("" ::: "memory");
            if (t == 0) ((PG8_LAS unsigned*)P)[14] = (unsigned)u.pm;
        }
        float rs[2][4];
#pragma unroll
        for (int ai = 0; ai < 2; ++ai)
#pragma unroll
            for (int m = 0; m < 4; ++m) rs[ai][m] = RS[u.half * HALF + (ai < nai ? ai : 0) * HALF + wr * 64 + m * 16 + fr];
        const PG8_LAS float* bp = (const PG8_LAS float*)((PG8_LAS unsigned char*)P - 256 + (lds_int(P + 11) ? 1024 : 4096)) + u.idx * BM + wc * 32 + 8 * fq;
        f32x4 bv[2][2];
#pragma unroll
        for (int bj = 0; bj < 2; ++bj)
#pragma unroll
            for (int n = 0; n < 2; ++n) bv[bj][n] = *(const PG8_LAS f32x4*)(bp + bj * HALF + 4 * n);
        if (u.pn < pn0 && lds_int(P + 11) != 0 && u.pn < 4) {
            const PG8_GAS float* const qkg = (const PG8_GAS float*)lds_ptr<const float>(P + 12);
            PG8_LAS float* X = (PG8_LAS float*)((PG8_LAS unsigned char*)P - 256 + 4096);
            const int col0 = u.pn * BM + wc * 32 + 8 * fq;
#pragma unroll
            for (int ai = 0; ai < 2; ++ai)
#pragma unroll
                for (int m = 0; m < 4; ++m)
#pragma unroll
                    for (int bj = 0; bj < 2; ++bj) { const f32x4 v0 = acc[ai][bj][m][0] * rs[ai][m] + bv[bj][0], v1 = acc[ai][bj][m][1] * rs[ai][m] + bv[bj][1];
                        float ss = ((v0[0] * v0[0] + v0[1] * v0[1]) + (v0[2] * v0[2] + v0[3] * v0[3])) + ((v1[0] * v1[0] + v1[1] * v1[1]) + (v1[2] * v1[2] + v1[3] * v1[3]));
                        ss += __shfl_xor(ss, 16); ss += __shfl_xor(ss, 32);
                        if (fq == 0) X[((ai * HALF + wr * 64 + m * 16 + fr) * 2 + bj) * 4 + wc] = ss; }
            asm volatile("s_waitcnt lgkmcnt(0)" ::: "memory"); __builtin_amdgcn_s_barrier(); asm volatile("" ::: "memory");
            const float qs = (u.pn < 2) ? 0.125f * 1.4426950408889634f : 1.0f;
            const PG8_GAS float* gp = qkg + (u.pn < 2 ? 0 : 64) + (wc & 1) * 32 + 8 * fq;
            const f32x4 g0 = *(const PG8_GAS f32x4*)gp, g1 = *(const PG8_GAS f32x4*)(gp + 4);
#pragma unroll
            for (int ai = 0; ai < 2; ++ai)
#pragma unroll
                for (int m = 0; m < 4; ++m) { PG8_GAS bf16_t* rowp = O + (size_t)(row0 + ai * HALF + m * 16) * ldc + col0;
#pragma unroll
                    for (int bj = 0; bj < 2; ++bj) { const PG8_LAS float* xp = X + ((ai * HALF + wr * 64 + m * 16 + fr) * 2 + bj) * 4;
                        const float tot = xp[wc] + xp[wc ^ 1], rn = (1.0f / sqrtf(tot * (1.0f / 64.0f) + 1e-6f)) * qs;
                        const f32x4 v0 = (acc[ai][bj][m][0] * rs[ai][m] + bv[bj][0]) * rn * g0, v1 = (acc[ai][bj][m][1] * rs[ai][m] + bv[bj][1]) * rn * g1;
                        u32x4 w; w.x = cvt_pk_bf16(v0[0], v0[1]); w.y = cvt_pk_bf16(v0[2], v0[3]); w.z = cvt_pk_bf16(v1[0], v1[1]); w.w = cvt_pk_bf16(v1[2], v1[3]);
                        *(PG8_GAS u32x4*)(rowp + bj * HALF) = w; } }
        } else if (u.pn < pn0) {
            const int col0 = u.pn * BM + wc * 32 + 8 * fq;
#pragma unroll
            for (int ai = 0; ai < 2; ++ai) if (ai < nai)
#pragma unroll
                for (int m = 0; m < 4; ++m) { PG8_GAS bf16_t* rowp = O + (size_t)(row0 + ai * HALF + m * 16) * ldc + col0;
#pragma unroll
                    for (int bj = 0; bj < 2; ++bj) { const f32x4 v0 = acc[ai][bj][m][0] * rs[ai][m] + bv[bj][0], v1 = acc[ai][bj][m][1] * rs[ai][m] + bv[bj][1];
                        u32x4 w; w.x = cvt_pk_bf16(v0[0], v0[1]); w.y = cvt_pk_bf16(v0[2], v0[3]); w.z = cvt_pk_bf16(v1[0], v1[1]); w.w = cvt_pk_bf16(v1[2], v1[3]);
                        *(PG8_GAS u32x4*)(rowp + bj * HALF) = w; } }
        } else {
            const int col0 = colbase + (u.pn - pn0) * HALF + wc * 32 + 8 * fq;
#pragma unroll
            for (int ai = 0; ai < 2; ++ai) if (ai < nai)
#pragma unroll
                for (int m = 0; m < 4; ++m) { PG8_GAS bf16_t* rowp = O + (size_t)(row0 + ai * HALF + m * 16) * ldc + col0;
                    f32x4 g0 = acc[ai][0][m][0] * rs[ai][m] + bv[0][0], g1 = acc[ai][0][m][1] * rs[ai][m] + bv[0][1]; const f32x4 u0 = acc[ai][1][m][0] * rs[ai][m] + bv[1][0], u1 = acc[ai][1][m][1] * rs[ai][m] + bv[1][1];
                    if (act_silu) {
#pragma unroll
                        for (int e = 0; e < 4; ++e) { g0[e] = silu_f(g0[e]); g1[e] = silu_f(g1[e]); } }
                    g0 = g0 * u0; g1 = g1 * u1;
                    u32x4 w; w.x = cvt_pk_bf16(g0[0], g0[1]); w.y = cvt_pk_bf16(g0[2], g0[3]); w.z = cvt_pk_bf16(g1[0], g1[1]); w.w = cvt_pk_bf16(g1[2], g1[3]);
                    *(PG8_GAS u32x4*)rowp = w; }
        }
    }
};
struct EpiRes {
    static constexpr bool PERM = true, AFTER_DRAIN = false;
    const PG8_LAS unsigned* P;
    static constexpr int gstride = 9216, rows_per_batch = 8192;
    static __device__ __forceinline__ void put(PG8_LAS unsigned* P, const float* base, float* out, const float* gate, float gs, const float* nxt_g, const float* nxt_scale, bf16_t* xg, float* rowss, int has_nxt) {
        lds_put(P, base); lds_put(P + 2, out); lds_put(P + 4, gate); lds_put(P + 6, nxt_g); lds_put(P + 8, nxt_scale); lds_put(P + 10, xg); lds_put(P + 12, rowss); P[14] = __float_as_uint(gs); P[15] = has_nxt; }
    __device__ __forceinline__ void operator()(const f32x4 (&acc)[2][2][4][2], const Unit& u, int wr, int wc, int fr, int fq) const {
        const PG8_GAS float* const base = (const PG8_GAS float*)lds_ptr<const float>(P); PG8_GAS float* const out = (PG8_GAS float*)lds_ptr<float>(P + 2); const PG8_GAS float* const gate = (const PG8_GAS float*)lds_ptr<const float>(P + 4);
        const PG8_GAS float* const nxt_g = (const PG8_GAS float*)lds_ptr<const float>(P + 6); const PG8_GAS float* const nxt_scale = (const PG8_GAS float*)lds_ptr<const float>(P + 8);
        PG8_GAS bf16_t* const xg = (PG8_GAS bf16_t*)lds_ptr<bf16_t>(P + 10); PG8_GAS float* const rowss = (PG8_GAS float*)lds_ptr<float>(P + 12);
        const float gs = __uint_as_float((unsigned)lds_int(P + 14)); const int has_nxt = lds_int(P + 15);
        const int row0 = u.pm * BM + wr * 64 + fr, col0 = u.pn * BM + wc * 32 + 8 * fq;
        const int b = (u.pm * BM) / rows_per_batch;
        const PG8_GAS float* gp = gate + (size_t)b * gstride + col0;
        f32x4 bx[3][2][2];
#define PG8_LDROW(it_, buf_) do { const size_t off_ = (size_t)(row0 + ((it_) >> 2) * HALF + ((it_) & 3) * 16) * 1024 + col0; \
            _Pragma("unroll") for (int bj = 0; bj < 2; ++bj) { bx[buf_][bj][0] = *(const PG8_GAS f32x4*)(base + off_ + bj * HALF); bx[buf_][bj][1] = *(const PG8_GAS f32x4*)(base + off_ + bj * HALF + 4); } } while (0)
        PG8_LDROW(0, 0); PG8_LDROW(1, 1);
        f32x4 gv[2][2], gm[2][2];
#pragma unroll
        for (int bj = 0; bj < 2; ++bj)
#pragma unroll
            for (int n = 0; n < 2; ++n) { gv[bj][n] = *(const PG8_GAS f32x4*)(gp + bj * HALF + 4 * n) * gs;
                gm[bj][n] = *(const PG8_GAS f32x4*)(nxt_g + col0 + bj * HALF + 4 * n) * (*(const PG8_GAS f32x4*)(nxt_scale + (size_t)b * gstride + col0 + bj * HALF + 4 * n) + 1.0f); }
#pragma unroll
        for (int it = 0; it < 8; ++it) { const int ai = it >> 2, m = it & 3; const int row = row0 + ai * HALF + m * 16; const size_t off = (size_t)row * 1024 + col0; float ss = 0.f;
            if (it + 2 < 8) PG8_LDROW(it + 2, (it + 2) % 3);
#pragma unroll
            for (int bj = 0; bj < 2; ++bj) {
                const f32x4 x0 = bx[it % 3][bj][0] + gv[bj][0] * acc[ai][bj][m][0], x1 = bx[it % 3][bj][1] + gv[bj][1] * acc[ai][bj][m][1];
                *(PG8_GAS f32x4*)(out + off + bj * HALF) = x0; *(PG8_GAS f32x4*)(out + off + bj * HALF + 4) = x1;
                if (has_nxt) { ss += ((x0[0] * x0[0] + x0[1] * x0[1]) + (x0[2] * x0[2] + x0[3] * x0[3])) + ((x1[0] * x1[0] + x1[1] * x1[1]) + (x1[2] * x1[2] + x1[3] * x1[3]));
                    const f32x4 y0 = x0 * gm[bj][0], y1 = x1 * gm[bj][1];
                    u32x4 w; w.x = cvt_pk_bf16(y0[0], y0[1]); w.y = cvt_pk_bf16(y0[2], y0[3]); w.z = cvt_pk_bf16(y1[0], y1[1]); w.w = cvt_pk_bf16(y1[2], y1[3]);
                    *(PG8_GAS u32x4*)(xg + off + bj * HALF) = w; } }
            if (has_nxt) { ss += __shfl_xor(ss, 16); ss += __shfl_xor(ss, 32); if (fq == 0) rowss[(size_t)row * 16 + u.pn * 4 + wc] = ss; } }
#undef PG8_LDROW
    }
};

template <class Epi, class Sched, bool ALIGN_EPI = false, bool SP2 = false>
__device__ __forceinline__ void gemm_phase(PG8_LAS unsigned char* lds, const Gemm g, const Sched& S, const Epi& E, const int tid_in) {
    int tid_o = tid_in; asm volatile("" : "+v"(tid_o));
    const int tid = tid_o, wid = __builtin_amdgcn_readfirstlane(tid >> 6), lane = tid & 63, wr = wid >> 2, wc = wid & 3, fr = lane & 15, fq = lane >> 4;
    const int K = g.K, nt = K / BK;
    unsigned voffA[2], voffB[2];
#pragma unroll
    for (int i = 0; i < 2; ++i) { int R, C; stage_rc(tid * 16 + i * 8192, R, C); const int Rb = Epi::PERM ? ((R & ~31) + perm32(R & 31)) : R;
        voffA[i] = (unsigned)(R * K + C) * 2u; voffB[i] = (g.blin & 1) ? (unsigned)(tid * 16 + i * 8192) : (unsigned)(Rb * K + C) * 2u; }
    const size_t kstep = (size_t)(BK * 2);
    const size_t kstepB = (g.blin & 1) ? (size_t)16384 : kstep;
    const size_t hstep = (size_t)HALF * K * 2;
    const size_t tstep = 2 * hstep;
    const unsigned ldsbase = (unsigned)__builtin_amdgcn_readfirstlane((int)(unsigned)(uintptr_t)lds);
    const unsigned ldsw = (unsigned)wid * 1024u;
    const int aoff = lds_byte(wr * 64 + fr, fq * 8), boff = lds_byte(wc * 32 + fr, fq * 8);
#define PG8_SA(b, h) (((b) * 2 + (h)) * HTB)
#define PG8_SB(b, h) ((4 + (b) * 2 + (h)) * HTB)
#define PG8_STAGE(bufoff, gbase, voff) do { _Pragma("unroll") for (int _i = 0; _i < 2; ++_i) { unsigned keep_; \
        asm volatile("s_mov_b32 %0, m0\n\ts_mov_b32 m0, %3\n\ts_nop 0\n\tglobal_load_lds_dwordx4 %1, %2\n\ts_mov_b32 m0, %0" : "=&s"(keep_) \
            : "v"((voff)[_i]), "s"((const char*)(gbase)), "s"(ldsbase + (unsigned)(bufoff) + ldsw + (unsigned)(_i * 8192)) : "memory"); } } while (0)
#define PG8_LDA(dst, b, h) do { _Pragma("unroll") for (int m = 0; m < 4; ++m) _Pragma("unroll") for (int k = 0; k < 2; ++k) dst[m][k] = *(const PG8_LAS bf16x8*)(lds + PG8_SA(b, h) + aoff + m * 2048 + k * 1024); } while (0)
#define PG8_LDB(dst, b, h) do { _Pragma("unroll") for (int n = 0; n < 2; ++n) _Pragma("unroll") for (int k = 0; k < 2; ++k) dst[n][k] = *(const PG8_LAS bf16x8*)(lds + PG8_SB(b, h) + boff + n * 2048 + k * 1024); } while (0)
#define PG8_MMA(ai, bj, At, Bt) do { __builtin_amdgcn_s_setprio(1); _Pragma("unroll") for (int m = 0; m < 4; ++m) _Pragma("unroll") for (int n = 0; n < 2; ++n) _Pragma("unroll") for (int k = 0; k < 2; ++k) \
        acc[ai][bj][m][n] = __builtin_amdgcn_mfma_f32_16x16x32_bf16(Bt[n][k], At[m][k], acc[ai][bj][m][n], 0, 0, 0); __builtin_amdgcn_s_setprio(0); } while (0)
#define PG8_WAIT_V(n) asm volatile("s_waitcnt vmcnt(" #n ")" ::: "memory")
#define PG8_WAIT_L(n) asm volatile("s_waitcnt lgkmcnt(" #n ")" ::: "memory")
#define PG8_BAR __builtin_amdgcn_s_barrier()
#define PG8_SCHED __builtin_amdgcn_sched_barrier(0)
    Unit cur, nxt; int ui = 0;
    if (!S.next(0, cur)) return;
    f32x4 acc[2][2][4][2];
#pragma unroll
    for (int a = 0; a < 2; ++a)
#pragma unroll
        for (int b = 0; b < 2; ++b)
#pragma unroll
            for (int m = 0; m < 4; ++m)
#pragma unroll
                for (int n = 0; n < 2; ++n) acc[a][b][m][n] = (f32x4){0.f, 0.f, 0.f, 0.f};
    bf16x8 At[4][2], B0[2][2], B1[2][2];
    const char* cA = (const char*)g.A + (size_t)cur.pm * tstep + (size_t)cur.half * hstep; const char* cB = (const char*)g.Bt + (size_t)cur.pn * tstep;
    S.a_ready(cur);
    if constexpr (SP2) {
        PG8_STAGE(PG8_SB(0, 0), cB, voffB); PG8_STAGE(PG8_SB(0, 1), cB + hstep, voffB); PG8_STAGE(PG8_SA(0, 0), cA, voffA); PG8_STAGE(PG8_SA(0, 1), cA + hstep, voffA);
        if (wr == 1) PG8_BAR;
        PG8_WAIT_V(2); PG8_BAR;
        PG8_STAGE(PG8_SB(1, 0), cB + kstepB, voffB); PG8_STAGE(PG8_SA(1, 0), cA + kstep, voffA); PG8_STAGE(PG8_SB(1, 1), cB + hstep + kstepB, voffB);
        PG8_WAIT_V(6); PG8_BAR;
    } else {
        PG8_STAGE(PG8_SB(0, 0), cB, voffB); PG8_STAGE(PG8_SA(0, 0), cA, voffA); PG8_STAGE(PG8_SB(0, 1), cB + hstep, voffB); PG8_STAGE(PG8_SA(0, 1), cA + hstep, voffA);
        if (wr == 1) PG8_BAR;
        PG8_WAIT_V(4); PG8_BAR;
        PG8_STAGE(PG8_SB(1, 0), cB + kstepB, voffB); PG8_STAGE(PG8_SA(1, 0), cA + kstep, voffA); PG8_STAGE(PG8_SB(1, 1), cB + hstep + kstepB, voffB);
        PG8_WAIT_V(6); PG8_BAR;
    }
    for (;;) {
        const bool has_next = S.next(ui + 1, nxt);
        const char* nA = has_next ? (const char*)g.A + (size_t)nxt.pm * tstep + (size_t)nxt.half * hstep : cA; const char* nB = has_next ? (const char*)g.Bt + (size_t)nxt.pn * tstep : cB;
        const bool narrow_u = cur.narrow != 0;
        for (int t = 0; t < nt; t += 2) {
            const bool last = (t == nt - 2);
            const char* a1 = cA + (size_t)(t + 1) * kstep;
            const char* a2 = last ? nA : cA + (size_t)(t + 2) * kstep; const char* b2 = last ? nB : cB + (size_t)(t + 2) * kstepB;
            const char* a3 = a2 + kstep; const char* b3 = b2 + kstepB;
            if (last && has_next) S.a_ready(nxt);
            if constexpr (SP2) {
            PG8_LDB(B0, 0, 0); PG8_LDB(B1, 0, 1); PG8_SCHED; PG8_LDA(At, 0, 0); PG8_STAGE(PG8_SA(1, 1), a1 + hstep, voffA);
            PG8_WAIT_V(8); PG8_WAIT_L(0); PG8_BAR; PG8_MMA(0, 0, At, B0); PG8_MMA(0, 1, At, B1); PG8_BAR; PG8_SCHED;
            PG8_LDA(At, 0, 1); PG8_STAGE(PG8_SB(0, 0), b2, voffB); PG8_STAGE(PG8_SB(0, 1), b2 + hstep, voffB); PG8_STAGE(PG8_SA(0, 0), a2, voffA);
            PG8_WAIT_V(8); PG8_WAIT_L(0); PG8_BAR; if (!narrow_u) { PG8_MMA(1, 0, At, B0); PG8_MMA(1, 1, At, B1); } PG8_BAR; PG8_SCHED;
            PG8_LDB(B0, 1, 0); PG8_LDB(B1, 1, 1); PG8_SCHED; PG8_LDA(At, 1, 0); PG8_STAGE(PG8_SA(0, 1), a2 + hstep, voffA);
            PG8_WAIT_V(8); PG8_WAIT_L(0); PG8_BAR; PG8_MMA(0, 0, At, B0); PG8_MMA(0, 1, At, B1); PG8_BAR; PG8_SCHED;
            PG8_LDA(At, 1, 1); PG8_STAGE(PG8_SB(1, 0), b3, voffB); PG8_STAGE(PG8_SB(1, 1), b3 + hstep, voffB); PG8_STAGE(PG8_SA(1, 0), a3, voffA);
            PG8_WAIT_V(8); PG8_WAIT_L(0); PG8_BAR; if (!narrow_u) { PG8_MMA(1, 0, At, B0); PG8_MMA(1, 1, At, B1); } PG8_BAR; PG8_SCHED;
            } else {
            PG8_LDB(B0, 0, 0); PG8_SCHED; PG8_LDA(At, 0, 0); PG8_STAGE(PG8_SA(1, 1), a1 + hstep, voffA);
            PG8_WAIT_L(8); PG8_BAR; PG8_WAIT_L(0); PG8_MMA(0, 0, At, B0); PG8_BAR; PG8_SCHED;
            PG8_LDB(B1, 0, 1); PG8_STAGE(PG8_SB(0, 0), b2, voffB);
            PG8_BAR; PG8_WAIT_L(0); PG8_MMA(0, 1, At, B1); PG8_BAR;
            PG8_LDA(At, 0, 1); PG8_STAGE(PG8_SA(0, 0), a2, voffA);
            PG8_BAR; PG8_WAIT_L(0); PG8_MMA(1, 0, At, B0); PG8_BAR; PG8_SCHED;
            PG8_STAGE(PG8_SB(0, 1), b2 + hstep, voffB);
            PG8_WAIT_V(6); PG8_BAR; PG8_MMA(1, 1, At, B1); PG8_BAR;
            PG8_LDB(B0, 1, 0); PG8_SCHED; PG8_LDA(At, 1, 0); PG8_STAGE(PG8_SA(0, 1), a2 + hstep, voffA);
            PG8_WAIT_L(8); PG8_BAR; PG8_WAIT_L(0); PG8_MMA(0, 0, At, B0); PG8_BAR; PG8_SCHED;
            PG8_LDB(B1, 1, 1); PG8_STAGE(PG8_SB(1, 0), b3, voffB);
            PG8_BAR; PG8_WAIT_L(0); PG8_MMA(0, 1, At, B1); PG8_BAR;
            PG8_LDA(At, 1, 1); PG8_STAGE(PG8_SA(1, 0), a3, voffA);
            PG8_BAR; PG8_WAIT_L(0); PG8_MMA(1, 0, At, B0); PG8_BAR; PG8_SCHED;
            PG8_STAGE(PG8_SB(1, 1), b3 + hstep, voffB);
            PG8_WAIT_V(6); PG8_BAR; PG8_MMA(1, 1, At, B1); PG8_BAR;
            }
        }
        if constexpr (ALIGN_EPI) { if (wr == 0) PG8_BAR; }
        if constexpr (!Epi::AFTER_DRAIN) { E(acc, cur, wr, wc, fr, fq); S.done(cur); }
        if (!has_next) break;
#pragma unroll
        for (int a = 0; a < 2; ++a)
#pragma unroll
            for (int b = 0; b < 2; ++b)
#pragma unroll
                for (int m = 0; m < 4; ++m)
#pragma unroll
                    for (int n = 0; n < 2; ++n) acc[a][b][m][n] = (f32x4){0.f, 0.f, 0.f, 0.f};
        cur = nxt; cA = nA; cB = nB; ++ui;
        if constexpr (ALIGN_EPI) { if (wr == 1) PG8_BAR; }
    }
    PG8_WAIT_V(0);
    if constexpr (!ALIGN_EPI) { if (wr == 0) PG8_BAR; }
    PG8_BAR;
    if constexpr (Epi::AFTER_DRAIN) { E.fused(acc, cur, wr, wc, fr, fq, lds, wid, lane); S.done(cur); }
#undef PG8_SA
#undef PG8_SB
#undef PG8_STAGE
#undef PG8_LDA
#undef PG8_LDB
#undef PG8_MMA
#undef PG8_WAIT_V
#undef PG8_WAIT_L
#undef PG8_BAR
#undef PG8_SCHED
}
}
#ifndef PROBE_BLIN
#define PROBE_BLIN 0
#endif
#ifndef PROBE_ATT
#define PROBE_ATT 0
#endif
#ifndef PROBE
#define PROBE 0
#endif
#define LAS __attribute__((address_space(3)))
typedef unsigned short bf16;
typedef short bf16x8 __attribute__((ext_vector_type(8)));
typedef short s16x4 __attribute__((ext_vector_type(4)));
typedef short v4i16_t __attribute__((ext_vector_type(4)));
typedef float f32x4 __attribute__((ext_vector_type(4)));
typedef float f32x16 __attribute__((ext_vector_type(16)));
typedef unsigned u32x4 __attribute__((ext_vector_type(4)));
typedef unsigned u32x2 __attribute__((ext_vector_type(2)));

constexpr int NWAVES = 8, NTHR = 512;
constexpr int BATCH = 2, SEQ = 8192, DM = 1024, FF = 2816, M = BATCH * SEQ, NMOD = 9 * DM;
constexpr float EPS = 1e-6f;
constexpr size_t MiB = 1u << 20;
constexpr size_t WS_MOD = 1 * MiB;
constexpr size_t WS_WGU = 2 * MiB;
constexpr size_t WS_WD = WS_WGU + 8 * 11 * MiB;
constexpr size_t WS_WINAB = WS_WD + 44 * MiB;
constexpr size_t WS_WOUTAB = WS_WINAB + 8 * MiB;
constexpr size_t WS_WINC = WS_WOUTAB + 4 * MiB;
constexpr size_t WS_WOUTC = WS_WINC + 12 * MiB;
constexpr size_t WS_H = WS_WOUTC + 4 * MiB;
constexpr size_t WS_MIX = WS_H + 32 * MiB;
constexpr size_t WS_ACT = WS_MIX + 32 * MiB;
constexpr size_t WS_ROWSS = WS_ACT + 96 * MiB;
constexpr size_t WS_BIAS = WS_ROWSS + 1 * MiB;
constexpr size_t WS_END = WS_BIAS + 1 * MiB;
constexpr int BIAS_L = 28672, BIAS_MIX = 11264, BIAS_F2 = 17408;
constexpr int LDS_BYTES = 147456;

__device__ __forceinline__ unsigned pk2(float lo, float hi) { return pg8::cvt_pk_bf16(lo, hi); }
__device__ __forceinline__ float bflo(unsigned w) { return __uint_as_float(w << 16); }
__device__ __forceinline__ float bfhi(unsigned w) { return __uint_as_float(w & 0xffff0000u); }
__device__ __forceinline__ float wave_sum(float v) {
#pragma unroll
    for (int o = 1; o < 64; o <<= 1) v += __shfl_xor(v, o);
    return v;
}
__device__ __forceinline__ int fresh_tid(int wave0) { unsigned ones = ~0u; asm volatile("" : "+s"(ones)); int t = wave0 * 64 + (int)__builtin_amdgcn_mbcnt_hi(ones, __builtin_amdgcn_mbcnt_lo(ones, 0u)); asm volatile("" : "+v"(t)); return t; }
struct Args { const float* in[21]; float* out; unsigned char* ws; int ph_lo, ph_hi; };
typedef const Args __attribute__((address_space(4)))* KArgs;

__device__ __forceinline__ void tr_flush(bf16* WT, int ldk, int k0, int drow0, LAS float* scr, int lane) {
    asm volatile("s_waitcnt lgkmcnt(0)" ::: "memory");
    const int c = lane & 7;
#pragma unroll
    for (int j = 0; j < 4; ++j) { const int n = (lane >> 3) + 8 * j; const LAS float* s = scr + (8 * c) * 33 + n;
        u32x4 o; o.x = pk2(s[0 * 33], s[1 * 33]); o.y = pk2(s[2 * 33], s[3 * 33]); o.z = pk2(s[4 * 33], s[5 * 33]); o.w = pk2(s[6 * 33], s[7 * 33]);
        *(u32x4*)(WT + (size_t)(drow0 + n) * ldk + k0 + 8 * c) = o; }
    asm volatile("s_waitcnt lgkmcnt(0)" ::: "memory");
}
__device__ __forceinline__ void tr_item(const float* W, int ldn, int k0, int n0, bf16* WT, int ldk, int drow0, LAS float* scr, int lane) {
    float tv[32];
    const float* wp = W + (size_t)(k0 + (lane >> 5)) * ldn + n0 + (lane & 31);
#pragma unroll
    for (int i = 0; i < 32; ++i) tv[i] = wp[(size_t)(2 * i) * ldn];
#pragma unroll
    for (int i = 0; i < 32; ++i) scr[(2 * i + (lane >> 5)) * 33 + (lane & 31)] = tv[i];
    tr_flush(WT, ldk, k0, drow0, scr, lane);
}
__device__ __forceinline__ int glu_row(int f, int up) { return 256 * (f >> 7) + (f & 127) + (up ? 128 : 0); }

__device__ __forceinline__ void prep_phase(KArgs Ap, LAS unsigned char* lds, int tid, int lane, int wave) {
#define A (*Ap)
    const int G = gridDim.x, gw = blockIdx.x * NWAVES + wave, NGW = G * NWAVES;
    bf16* const WGU = (bf16*)(A.ws + WS_WGU); bf16* const WD = (bf16*)(A.ws + WS_WD); bf16* const WINAB = (bf16*)(A.ws + WS_WINAB);
    bf16* const WOUTAB = (bf16*)(A.ws + WS_WOUTAB); bf16* const WINC = (bf16*)(A.ws + WS_WINC); bf16* const WOUTC = (bf16*)(A.ws + WS_WOUTC);
    {
        LAS float* ca = (LAS float*)(lds);
        LAS float* red = (LAS float*)(lds + 8192);
        for (int i = tid; i < 2 * DM; i += NTHR) { const float v = A.in[1][i]; ca[i] = v / (1.0f + __expf(-v)); }
        __syncthreads();
        float* mod = (float*)(A.ws + WS_MOD);
        for (int task = blockIdx.x; task < 4 * 288; task += G) {
            const int l = task / 288, cgp = task % 288, col = lane & 31, par = lane >> 5;
            const float* wp = A.in[3] + (size_t)l * DM * NMOD + (size_t)(wave * 128 + par) * NMOD + cgp * 32 + col;
            float a0 = 0.f, a1 = 0.f;
#pragma unroll 16
            for (int k = 0; k < 64; ++k) { const float w = wp[(size_t)(2 * k) * NMOD]; a0 += ca[wave * 128 + 2 * k + par] * w; a1 += ca[DM + wave * 128 + 2 * k + par] * w; }
            a0 += __shfl_xor(a0, 32); a1 += __shfl_xor(a1, 32);
            if (lane < 32) { red[(wave * 2 + 0) * 32 + lane] = a0; red[(wave * 2 + 1) * 32 + lane] = a1; }
            __syncthreads();
            if (tid < 64) { const int b = tid >> 5, c = tid & 31; float s = 0.f;
#pragma unroll
                for (int w = 0; w < 8; ++w) s += red[(w * 2 + b) * 32 + c];
                mod[(size_t)(l * 2 + b) * NMOD + cgp * 32 + c] = s + A.in[4][(size_t)l * NMOD + cgp * 32 + c]; }
            __syncthreads();
        }
    }
    LAS float* scr = (LAS float*)(lds + wave * 16384);
    constexpr int N_FFN = 8 * 4224, N_INAB = 2 * 1024, N_OUTAB = 2 * 256, N_POOL = 2 * 256, N_INC = 2 * 1536, N_OUTC = 2 * 512;
    constexpr int NITEMS = N_FFN + N_INAB + N_OUTAB + N_POOL + N_INC + N_OUTC;
    for (int it = gw; it < NITEMS; it += NGW) {
        int r = it;
        if (r < N_FFN) { const int lj = r / 4224, q = r % 4224, which = q / 1408, q2 = q % 1408;
            if (which < 2) { const int kb = q2 / 88, nb = q2 % 88, f0 = 32 * nb;
                tr_item((which == 0 ? A.in[5] : A.in[6]) + (size_t)lj * DM * FF, FF, 64 * kb, f0, WGU + (size_t)lj * 5632 * 1024, 1024, glu_row(f0, which), scr, lane); }
            else { const int kb = q2 / 32, nb = q2 % 32; tr_item(A.in[7] + (size_t)lj * FF * DM, DM, 64 * kb, 32 * nb, WD + (size_t)lj * 1024 * FF, FF, 32 * nb, scr, lane); }
            continue; }
        r -= N_FFN;
        if (r < N_INAB) { const int e = r / 1024, q = r % 1024, kb = q / 64, nb = q % 64;
            tr_item(A.in[8] + (size_t)e * DM * 2048, 2048, 64 * kb, 32 * nb, WINAB + (size_t)e * 2048 * 1024, 1024, 32 * nb, scr, lane); continue; }
        r -= N_INAB;
        if (r < N_OUTAB) { const int e = r / 256, q = r % 256, kb = q / 32, nb = q % 32;
            tr_item(A.in[17] + (size_t)e * DM * DM, DM, 64 * kb, 32 * nb, WOUTAB + (size_t)e * DM * DM, DM, 32 * nb, scr, lane); continue; }
        r -= N_OUTAB;
        if (r < N_POOL) {
            const int e = r / 256, q = r % 256, kb = q / 32, nb = q % 32, g = kb >> 1, c0 = (kb & 1) * 64, n0 = 32 * nb;
            const float* pw = A.in[15] + ((size_t)(e * 4 + g) * 128 + c0 + lane) * 128;
            const float* ps = A.in[16] + e * 512 + g * 128;
            const float* wo = A.in[17] + (size_t)e * DM * DM + (size_t)(512 + g * 128) * DM + n0;
            float acc[32];
#pragma unroll
            for (int n = 0; n < 32; ++n) acc[n] = 0.f;
            for (int d = 0; d < 128; ++d) { const float pv = pw[d] * ps[d]; const float* wr = wo + (size_t)d * DM;
#pragma unroll
                for (int n = 0; n < 32; ++n) acc[n] += pv * wr[n]; }
#pragma unroll
            for (int n = 0; n < 32; ++n) scr[lane * 33 + n] = acc[n];
            tr_flush(WOUTAB + (size_t)e * DM * DM, DM, 512 + 64 * kb, n0, scr, lane); continue; }
        r -= N_POOL;
        if (r < N_INC) { const int o = r / 1536, q = r % 1536, kb = q / 96, nb = q % 96, c0 = 32 * nb;
            const int drow = c0 < 1024 ? c0 : (c0 < 2048 ? 1024 + glu_row(c0 - 1024, 0) : 1024 + glu_row(c0 - 2048, 1));
            tr_item(A.in[18] + (size_t)o * DM * 3072, 3072, 64 * kb, c0, WINC + (size_t)o * 3072 * 1024, 1024, drow, scr, lane); continue; }
        r -= N_INC;
        { const int o = r / 512, q = r % 512, kb = q / 32, nb = q % 32;
            tr_item(A.in[20] + (size_t)o * DM * DM, DM, 64 * kb, 32 * nb, WOUTC + (size_t)o * DM * DM, DM, 32 * nb, scr, lane); }
    }
}

#undef A
__device__ __forceinline__ void prep2_phase(KArgs Ap, int lane, int wave) {
#define A (*Ap)
    const int gw = blockIdx.x * NWAVES + wave, NGW = gridDim.x * NWAVES;
    const float* mod = (const float*)(A.ws + WS_MOD); float* bias = (float*)(A.ws + WS_BIAS);
    constexpr int ROWS_L = 5632 + 3072 + 5632, ITEMS_L = ROWS_L / 32;
    for (int it = gw; it < 4 * ITEMS_L; it += NGW) {
        const int l = it / ITEMS_L, r32 = (it % ITEMS_L) * 32, e = l >> 1;
        int j, n0, N; const bf16* W;
        if (r32 < 5632) { j = 0; n0 = r32; N = 5632; W = (const bf16*)(A.ws + WS_WGU) + (size_t)(l * 2) * 5632 * 1024; }
        else if (r32 < 5632 + 3072) { j = 1; n0 = r32 - 5632; N = (l & 1) ? 3072 : 2048; if (n0 >= N) continue;
            W = (l & 1) ? (const bf16*)(A.ws + WS_WINC) + (size_t)e * 3072 * 1024 : (const bf16*)(A.ws + WS_WINAB) + (size_t)e * 2048 * 1024; }
        else { j = 2; n0 = r32 - 5632 - 3072; N = 5632; W = (const bf16*)(A.ws + WS_WGU) + (size_t)(l * 2 + 1) * 5632 * 1024; }
        const float* sh0 = mod + (size_t)(l * 2) * NMOD + (3 * j) * DM + 16 * lane; const float* sh1 = sh0 + NMOD;
        float s0[16], s1[16];
#pragma unroll
        for (int q = 0; q < 4; ++q) { const f32x4 a = ((const f32x4*)sh0)[q], b = ((const f32x4*)sh1)[q];
            s0[4 * q] = a.x; s0[4 * q + 1] = a.y; s0[4 * q + 2] = a.z; s0[4 * q + 3] = a.w; s1[4 * q] = b.x; s1[4 * q + 1] = b.y; s1[4 * q + 2] = b.z; s1[4 * q + 3] = b.w; }
        float* bo = bias + (size_t)l * BIAS_L + (j == 0 ? 0 : (j == 1 ? BIAS_MIX : BIAS_F2));
        for (int rr = 0; rr < 32; rr += 4) {
            u32x4 w0[4], w1[4];
#pragma unroll
            for (int u = 0; u < 4; ++u) { const u32x4* wp = (const u32x4*)(W + (size_t)(n0 + rr + u) * 1024 + 16 * lane); w0[u] = wp[0]; w1[u] = wp[1]; }
#pragma unroll
            for (int u = 0; u < 4; ++u) {
                const unsigned ww[8] = {w0[u].x, w0[u].y, w0[u].z, w0[u].w, w1[u].x, w1[u].y, w1[u].z, w1[u].w};
                float a0 = 0.f, a1 = 0.f;
#pragma unroll
                for (int q = 0; q < 8; ++q) { const float lo = bflo(ww[q]), hi = bfhi(ww[q]); a0 += s0[2 * q] * lo + s0[2 * q + 1] * hi; a1 += s1[2 * q] * lo + s1[2 * q + 1] * hi; }
                a0 = wave_sum(a0); a1 = wave_sum(a1);
                if (lane == 0) { bo[n0 + rr + u] = a0; bo[N + n0 + rr + u] = a1; }
            }
        }
    }
    const float* g = A.in[2]; bf16* xg = (bf16*)(A.ws + WS_H); float* rowss = (float*)(A.ws + WS_ROWSS);
    for (int m0 = gw; m0 < M; m0 += 4 * NGW) {
        f32x4 v[4][4];
#pragma unroll
        for (int k4 = 0; k4 < 4; ++k4) { const int m = (m0 + k4 * NGW < M) ? m0 + k4 * NGW : m0; const f32x4* xr = (const f32x4*)(A.in[0] + (size_t)m * DM) + lane;
#pragma unroll
            for (int j = 0; j < 4; ++j) v[k4][j] = xr[64 * j]; }
#pragma unroll
        for (int k4 = 0; k4 < 4; ++k4) { const int m = m0 + k4 * NGW; if (m >= M) break;
            const int b = m / SEQ; const float* sc = mod + (size_t)b * NMOD + DM;
            u32x2* o8 = (u32x2*)(xg + (size_t)m * DM) + lane; float s = 0.f;
#pragma unroll
            for (int j = 0; j < 4; ++j) { const f32x4 vv = v[k4][j]; s += (vv.x * vv.x + vv.y * vv.y) + (vv.z * vv.z + vv.w * vv.w);
                const f32x4 y = vv * ((const f32x4*)g)[lane + 64 * j] * (((const f32x4*)sc)[lane + 64 * j] + 1.0f);
                u32x2 w; w.x = pk2(y.x, y.y); w.y = pk2(y.z, y.w); o8[64 * j] = w; }
            s = wave_sum(s);
            if (lane < 16) rowss[(size_t)m * 16 + lane] = (lane == 0) ? s : 0.f; }
    }
}
#undef A
__device__ __forceinline__ void pool_phase(const bf16* proj  , bf16* mix, int lane, int wave) {
    const int gw = blockIdx.x * NWAVES + wave, NGW = gridDim.x * NWAVES;
    const int g = lane >> 4, w = 2 << g;
    for (int m = gw; m < M; m += NGW) {
        const int t = m % SEQ;
        const bf16* up = proj + (size_t)m * 2048 + 1536 + 8 * lane;
        const u32x4 c = *(const u32x4*)up;
        float s[8] = {bflo(c.x), bfhi(c.x), bflo(c.y), bfhi(c.y), bflo(c.z), bfhi(c.z), bflo(c.w), bfhi(c.w)};
        float cur[8];
#pragma unroll
        for (int e = 0; e < 8; ++e) cur[e] = s[e];
        const int cnt = (t + 1 < w) ? t + 1 : w;
        u32x4 pv[15];
#pragma unroll
        for (int j = 1; j < 16; ++j) { pv[j - 1] = (u32x4){0u, 0u, 0u, 0u}; if (j < cnt) pv[j - 1] = *(const u32x4*)(up - (size_t)j * 2048); }
#pragma unroll
        for (int j = 0; j < 15; ++j) { const u32x4 p = pv[j];
            s[0] += bflo(p.x); s[1] += bfhi(p.x); s[2] += bflo(p.y); s[3] += bfhi(p.y); s[4] += bflo(p.z); s[5] += bfhi(p.z); s[6] += bflo(p.w); s[7] += bfhi(p.w); }
        const float inv = 1.0f / (float)cnt;
        u32x4 o; o.x = pk2(s[0] * inv - cur[0], s[1] * inv - cur[1]); o.y = pk2(s[2] * inv - cur[2], s[3] * inv - cur[3]);
        o.z = pk2(s[4] * inv - cur[4], s[5] * inv - cur[5]); o.w = pk2(s[6] * inv - cur[6], s[7] * inv - cur[7]);
        *(u32x4*)(mix + (size_t)m * DM + 512 + 8 * lane) = o;
    }
}

__device__ __forceinline__ void conv_phase(const bf16* __restrict__ proj  , bf16* __restrict__ mix, const float* __restrict__ cw  , int tid) {
    const int gt = blockIdx.x * NTHR + tid, NGT = gridDim.x * NTHR;
    for (int i0 = gt; i0 < M * 128; i0 += 4 * NGT)
#pragma unroll
    for (int k4 = 0; k4 < 4; ++k4) { const int i = i0 + k4 * NGT; if (i >= M * 128) break;
        const int m = i >> 7, c8 = (i & 127) * 8, t = m % SEQ;
        const bf16* bp = proj + (size_t)m * 2048 + c8; const bf16* vp = bp + 1024;
        const u32x4 bb = *(const u32x4*)bp, v0 = *(const u32x4*)vp;
        u32x4 v1 = (u32x4){0u, 0u, 0u, 0u}, v2 = (u32x4){0u, 0u, 0u, 0u};
        if (t >= 1) v1 = *(const u32x4*)(vp - 2048);
        if (t >= 2) v2 = *(const u32x4*)(vp - 4096);
        const f32x4 w0a = *(const f32x4*)(cw + c8), w0b = *(const f32x4*)(cw + c8 + 4), w1a = *(const f32x4*)(cw + 1024 + c8), w1b = *(const f32x4*)(cw + 1024 + c8 + 4),
                    w2a = *(const f32x4*)(cw + 2048 + c8), w2b = *(const f32x4*)(cw + 2048 + c8 + 4);
        float y[8];
#define CV(e, W0, W1, W2, word, HI) y[e] = (HI ? bfhi(bb.word) : bflo(bb.word)) * (W0 * (HI ? bfhi(v2.word) : bflo(v2.word)) + W1 * (HI ? bfhi(v1.word) : bflo(v1.word)) + W2 * (HI ? bfhi(v0.word) : bflo(v0.word)))
        CV(0, w0a.x, w1a.x, w2a.x, x, 0); CV(1, w0a.y, w1a.y, w2a.y, x, 1); CV(2, w0a.z, w1a.z, w2a.z, y, 0); CV(3, w0a.w, w1a.w, w2a.w, y, 1);
        CV(4, w0b.x, w1b.x, w2b.x, z, 0); CV(5, w0b.y, w1b.y, w2b.y, z, 1); CV(6, w0b.z, w1b.z, w2b.z, w, 0); CV(7, w0b.w, w1b.w, w2b.w, w, 1);
#undef CV
        u32x4 o; o.x = pk2(y[0], y[1]); o.y = pk2(y[2], y[3]); o.z = pk2(y[4], y[5]); o.w = pk2(y[6], y[7]);
        *(u32x4*)(mix + (size_t)m * DM + c8) = o;
    }
}

__device__ __forceinline__ void qknorm_phase(const bf16* proj, bf16* qkn  , const float* qkg  , int lane, int wave) {
    const int gw = blockIdx.x * NWAVES + wave, NGW = gridDim.x * NWAVES;
    const int isk = lane >> 5;
    const float* g = qkg + isk * 64 + ((16 * lane) & 63);
    float gv[16];
#pragma unroll
    for (int q = 0; q < 4; ++q) { const f32x4 a = ((const f32x4*)g)[q]; gv[4 * q] = a.x; gv[4 * q + 1] = a.y; gv[4 * q + 2] = a.z; gv[4 * q + 3] = a.w; }
    const float qs = isk ? 1.0f : 0.125f * 1.4426950408889634f;
    for (int m = gw; m < M; m += NGW) {
        const u32x4* p = (const u32x4*)(proj + (size_t)m * 2048 + 16 * lane); u32x4* po = (u32x4*)(qkn + (size_t)m * 1024 + 16 * lane);
        const u32x4 w0 = p[0], w1 = p[1];
        const unsigned ww[8] = {w0.x, w0.y, w0.z, w0.w, w1.x, w1.y, w1.z, w1.w};
        float f[16], ss = 0.f;
#pragma unroll
        for (int q = 0; q < 8; ++q) { f[2 * q] = bflo(ww[q]); f[2 * q + 1] = bfhi(ww[q]); ss += f[2 * q] * f[2 * q] + f[2 * q + 1] * f[2 * q + 1]; }
        ss += __shfl_xor(ss, 1); ss += __shfl_xor(ss, 2);
        const float rstd = (1.0f / sqrtf(ss * (1.0f / 64.0f) + EPS)) * qs;
        u32x4 o0, o1;
        o0.x = pk2(f[0] * rstd * gv[0], f[1] * rstd * gv[1]); o0.y = pk2(f[2] * rstd * gv[2], f[3] * rstd * gv[3]); o0.z = pk2(f[4] * rstd * gv[4], f[5] * rstd * gv[5]); o0.w = pk2(f[6] * rstd * gv[6], f[7] * rstd * gv[7]);
        o1.x = pk2(f[8] * rstd * gv[8], f[9] * rstd * gv[9]); o1.y = pk2(f[10] * rstd * gv[10], f[11] * rstd * gv[11]); o1.z = pk2(f[12] * rstd * gv[12], f[13] * rstd * gv[13]); o1.w = pk2(f[14] * rstd * gv[14], f[15] * rstd * gv[15]);
        po[0] = o0; po[1] = o1;
    }
}

namespace att {
constexpr int STAGE = 32768, NSTAGE = 4, OFF_V = 16384, OFF_WS = 131072 + 1024;
__device__ __forceinline__ int crow(int i, int h) { return (i & 3) + 8 * (i >> 2) + 4 * h; }
__device__ __forceinline__ s16x4 vtr(const LAS unsigned char* p) { return __builtin_bit_cast(s16x4, __builtin_amdgcn_ds_read_tr16_b64_v4i16((LAS v4i16_t*)p)); }
#define MFMA32(a, b, c) __builtin_amdgcn_mfma_f32_32x32x16_bf16((a), (b), (c), 0, 0, 0)
__device__ __forceinline__ float max3f(float a, float b, float c) { float r; asm("v_max3_f32 %0, %1, %2, %3" : "=v"(r) : "v"(a), "v"(b), "v"(c)); return r; }
__device__ __forceinline__ float max2f(float a, float b) { float r; asm("v_max_f32_e32 %0, %1, %2" : "=v"(r) : "v"(a), "v"(b)); return r; }
__device__ __forceinline__ void glds16(const void* gsrc, unsigned lds_dst) { unsigned keep;
    asm volatile("s_mov_b32 %0, m0\n\ts_mov_b32 m0, %2\n\ts_nop 0\n\tglobal_load_lds_dwordx4 %1, off\n\ts_mov_b32 m0, %0" : "=&s"(keep) : "v"(gsrc), "s"(lds_dst) : "memory"); }
#define GLDS16(gp, lp) glds16((gp), (unsigned)__builtin_amdgcn_readfirstlane((int)(unsigned)(uintptr_t)(lp)))
__device__ __forceinline__ void glds16s(const void* sbase, unsigned voff, unsigned lds_dst) { unsigned keep;
    asm volatile("s_mov_b32 %0, m0\n\ts_mov_b32 m0, %3\n\ts_nop 0\n\tglobal_load_lds_dwordx4 %1, %2\n\ts_mov_b32 m0, %0" : "=&s"(keep) : "v"(voff), "s"(sbase), "s"(lds_dst) : "memory"); }
__device__ __forceinline__ void dma_tile(LAS unsigned char* st, const bf16* proj, const bf16* qkn, size_t rowbase, int hd, int t, int wid, unsigned koff, unsigned voff) {
    const unsigned ldsb = (unsigned)__builtin_amdgcn_readfirstlane((int)(unsigned)(uintptr_t)st);
    const char* kb = (const char*)(qkn + (rowbase + (size_t)(64 * t)) * 2048 + 512 + hd * 128 + 8 * wid);
    glds16s(kb, koff, ldsb + wid * 1024);
    glds16s(kb + 128, koff, ldsb + 8192 + wid * 1024);
#pragma unroll
    for (int i = 0; i < 2; ++i) { const int s = 2 * wid + i, db = s >> 2, kvg = s & 3;
        const char* vb = (const char*)(proj + (rowbase + (size_t)(64 * t + 16 * kvg)) * 2048 + 1024 + hd * 128 + 32 * db);
        glds16s(vb, voff, ldsb + OFF_V + s * 1024); }
}

template <bool MASKED> __device__ __forceinline__ void s_step(const LAS unsigned char* kb, const bf16x8 (&qr)[4], f32x16& negm, float& mref, f32x16 (&o)[4], float& lsum, bf16x8 (&pa)[4],
                                                            LAS float* wsf, int r, int h, int thr, bool first) {
    f32x16 p0, p1;
    bf16x8 ka[4], kc[4];
#pragma unroll
    for (int d0 = 0; d0 < 4; ++d0) { ka[d0] = *(const LAS bf16x8*)(kb + d0 * 2048); kc[d0] = *(const LAS bf16x8*)(kb + d0 * 2048 + 512); }
    __builtin_amdgcn_sched_barrier(0);
    __builtin_amdgcn_s_setprio(1);
    p0 = MFMA32(ka[0], qr[0], negm); p1 = MFMA32(kc[0], qr[0], negm);
#pragma unroll
    for (int d0 = 1; d0 < 4; ++d0) { p0 = MFMA32(ka[d0], qr[d0], p0); p1 = MFMA32(kc[d0], qr[d0], p1); }
    __builtin_amdgcn_s_setprio(0);
    if (MASKED) {
#pragma unroll
        for (int i = 0; i < 16; ++i) { const int kl = crow(i, h); if (kl > thr) p0[i] = -INFINITY; if (kl + 32 > thr) p1[i] = -INFINITY; } }
    asm volatile("s_nop 15\n\ts_nop 7" : "+v"(p0), "+v"(p1));
    float mx;
    { float a = max3f(p0[0], p0[1], p1[0]), c = max3f(p0[2], p0[3], p1[1]); a = max3f(a, p1[2], p1[3]);
#pragma unroll
      for (int i = 4; i < 16; i += 4) { a = max3f(a, p0[i], p0[i + 1]); c = max3f(c, p0[i + 2], p0[i + 3]); a = max3f(a, p1[i], p1[i + 1]); c = max3f(c, p1[i + 2], p1[i + 3]); }
      mx = max2f(a, c);
      const auto rr = __builtin_amdgcn_permlane32_swap(__float_as_uint(mx), __float_as_uint(mx), false, false);
      mx = max2f(__uint_as_float(rr[0]), __uint_as_float(rr[1])); }
    if (first || __any(mx > 8.0f)) {
        const float dl = first ? mx : fmaxf(mx, 0.f), alpha = __builtin_amdgcn_exp2f(-dl);
        mref += dl;
#pragma unroll
        for (int i = 0; i < 16; ++i) { p0[i] -= dl; p1[i] -= dl; negm[i] = -mref; }
        if (h == 0) wsf[r] = alpha;
        asm volatile("s_waitcnt lgkmcnt(0)" ::: "memory");
#pragma unroll
        for (int i = 0; i < 16; ++i) { const float a = wsf[crow(i, h)];
#pragma unroll
            for (int d = 0; d < 4; ++d) o[d][i] *= a; }
        lsum *= alpha;
    }
    float ps0 = 0.f, ps1 = 0.f;
#pragma unroll
    for (int i = 0; i < 16; ++i) { p0[i] = __builtin_amdgcn_exp2f(p0[i]); p1[i] = __builtin_amdgcn_exp2f(p1[i]); ps0 += p0[i]; ps1 += p1[i]; }
    lsum += ps0 + ps1;
    u32x4 w;
    w.x = pk2(p0[0], p0[1]); w.y = pk2(p0[2], p0[3]); w.z = pk2(p0[4], p0[5]); w.w = pk2(p0[6], p0[7]); pa[0] = __builtin_bit_cast(bf16x8, w);
    w.x = pk2(p0[8], p0[9]); w.y = pk2(p0[10], p0[11]); w.z = pk2(p0[12], p0[13]); w.w = pk2(p0[14], p0[15]); pa[1] = __builtin_bit_cast(bf16x8, w);
    w.x = pk2(p1[0], p1[1]); w.y = pk2(p1[2], p1[3]); w.z = pk2(p1[4], p1[5]); w.w = pk2(p1[6], p1[7]); pa[2] = __builtin_bit_cast(bf16x8, w);
    w.x = pk2(p1[8], p1[9]); w.y = pk2(p1[10], p1[11]); w.z = pk2(p1[12], p1[13]); w.w = pk2(p1[14], p1[15]); pa[3] = __builtin_bit_cast(bf16x8, w);
}
__device__ __forceinline__ void pv_step(const LAS unsigned char* vb, const bf16x8 (&pa)[4], f32x16 (&o)[4]) {
    s16x4 vlo[4][4], vhi[4][4];
#pragma unroll
    for (int db = 0; db < 4; ++db)
#pragma unroll
        for (int s = 0; s < 4; ++s) { vlo[db][s] = vtr(vb + (db * 4 + s) * 1024); vhi[db][s] = vtr(vb + (db * 4 + s) * 1024 + 512); }
    __builtin_amdgcn_sched_barrier(0);
    __builtin_amdgcn_s_setprio(1);
#pragma unroll
    for (int db = 0; db < 4; ++db)
#pragma unroll
        for (int s = 0; s < 4; ++s) { const bf16x8 vf = __builtin_shufflevector(vlo[db][s], vhi[db][s], 0, 1, 2, 3, 4, 5, 6, 7);
            o[db] = MFMA32(pa[s], vf, o[db]); }
    __builtin_amdgcn_s_setprio(0);
}

template <int MODE  > __device__ __forceinline__ void attn_unit(LAS unsigned char* lds, const bf16* proj, const bf16* qkn, bf16* mix, int b, int hd, int qb, const float* subg  , float lam, float oscale, int tid) {
    const int lane = tid & 63, r = lane & 31, h = lane >> 5; const int wid = __builtin_amdgcn_readfirstlane(tid >> 6);
    const int sub = wid >> 2, wq = wid & 3;
    const size_t rowbase = (size_t)b * SEQ; const int q0 = qb * 128, qw = q0 + wq * 32;
    const int NT = 2 * qb + 2, ntw = (qw >> 6) + 1;
    LAS float* wsf = (LAS float*)(lds + OFF_WS) + wid * 64;
    const unsigned dkoff = (unsigned)lane * 4096u, dvoff = (unsigned)(lane >> 2) * 4096u + (unsigned)(lane & 3) * 16u;
#pragma unroll
    for (int j = 0; j < NSTAGE; ++j) if (j < NT) dma_tile(lds + j * STAGE, proj, qkn, rowbase, hd, j, wid, dkoff, dvoff);
    bf16x8 qr[4];
    { const bf16* qp = qkn + (rowbase + (size_t)(qw + r)) * 2048 + hd * 128 + sub * 64 + 8 * h;
#pragma unroll
      for (int d0 = 0; d0 < 4; ++d0) qr[d0] = *(const bf16x8*)(qp + 16 * d0); }
    f32x16 o[4], negm;
#pragma unroll
    for (int i = 0; i < 16; ++i) { o[0][i] = 0.f; o[1][i] = 0.f; o[2][i] = 0.f; o[3][i] = 0.f; negm[i] = 0.f; }
    float mref = 0.f, lsum = 0.f;
    bf16x8 pa[4];
#pragma unroll
    for (int s = 0; s < 4; ++s) pa[s] = (bf16x8){0, 0, 0, 0, 0, 0, 0, 0};
    const int vlane = (4 * h + ((lane & 15) >> 2)) * 64 + ((lane >> 4) & 1) * 32 + (lane & 3) * 8;
    const LAS unsigned char* kbase = lds + sub * 8192 + h * 1024 + r * 16;
    const LAS unsigned char* vbase = lds + OFF_V + vlane;
    asm volatile("s_waitcnt vmcnt(0)" ::: "memory");
    asm volatile("" : "+v"(qr[0]), "+v"(qr[1]), "+v"(qr[2]), "+v"(qr[3]));
    __builtin_amdgcn_s_barrier();
#define STEP_BEGIN(t_) do { const int k_ = (t_) + 2; if ((t_) >= 2 && k_ < NT) dma_tile(lds + (k_ & 3) * STAGE, proj, qkn, rowbase, hd, k_, wid, dkoff, dvoff); } while (0)
#define STEP_END(t_) do { if ((t_) >= 2 && (t_) + 2 < NT) asm volatile("s_waitcnt vmcnt(4)" ::: "memory"); else asm volatile("s_waitcnt vmcnt(0)" ::: "memory"); \
        asm volatile("s_waitcnt lgkmcnt(0)" ::: "memory"); __builtin_amdgcn_s_barrier(); } while (0)
#define KB(t_) (kbase + ((t_) & 3) * STAGE)
#define VB(t_) (vbase + ((t_) & 3) * STAGE)
    if (sub == 0) {
        int t = 0;
        for (; t < ntw - 1; ++t) { STEP_BEGIN(t); s_step<false>(KB(t), qr, negm, mref, o, lsum, pa, wsf, r, h, 0, t == 0); pv_step(VB(t), pa, o); STEP_END(t); }
        { STEP_BEGIN(t); s_step<true>(KB(t), qr, negm, mref, o, lsum, pa, wsf, r, h, qw + r - 64 * t, t == 0); pv_step(VB(t), pa, o); STEP_END(t); ++t; }
        for (; t < NT; ++t) { STEP_BEGIN(t); STEP_END(t); }
        asm volatile("s_waitcnt lgkmcnt(0)" ::: "memory"); __builtin_amdgcn_s_barrier();
    } else {
        int t = 0;
        { STEP_BEGIN(0); if (ntw > 1) s_step<false>(KB(0), qr, negm, mref, o, lsum, pa, wsf, r, h, 0, true); else s_step<true>(KB(0), qr, negm, mref, o, lsum, pa, wsf, r, h, qw + r, true); STEP_END(0); t = 1; }
        for (; t < ntw - 1; ++t) { STEP_BEGIN(t); pv_step(VB(t - 1), pa, o); s_step<false>(KB(t), qr, negm, mref, o, lsum, pa, wsf, r, h, 0, false); STEP_END(t); }
        if (t < ntw) { STEP_BEGIN(t); pv_step(VB(t - 1), pa, o); s_step<true>(KB(t), qr, negm, mref, o, lsum, pa, wsf, r, h, qw + r - 64 * t, false); STEP_END(t); ++t; }
        if (t < NT) { STEP_BEGIN(t); pv_step(VB(t - 1), pa, o); STEP_END(t); ++t; for (; t < NT; ++t) { STEP_BEGIN(t); STEP_END(t); } }
        else pv_step(VB(t - 1), pa, o);
        asm volatile("s_waitcnt lgkmcnt(0)" ::: "memory"); __builtin_amdgcn_s_barrier();
    }
#undef STEP_BEGIN
#undef STEP_END
#undef KB
#undef VB
    int lane_f = lane; asm volatile("" : "+v"(lane_f));
    const int r_f = lane_f & 31, h_f = lane_f >> 5;
    { const auto rr = __builtin_amdgcn_permlane32_swap(__float_as_uint(lsum), __float_as_uint(lsum), false, false); lsum = __uint_as_float(rr[0]) + __uint_as_float(rr[1]); }
    if (h_f == 0) wsf[r_f] = (sub ? lam : 1.0f) / lsum;
    asm volatile("s_waitcnt lgkmcnt(0)" ::: "memory");
#pragma unroll
    for (int i = 0; i < 16; ++i) { const float a = wsf[crow(i, h_f)];
#pragma unroll
        for (int d = 0; d < 4; ++d) o[d][i] *= a; }
    LAS float* xo = (LAS float*)(lds + wq * 16384);
    if (sub == 1) {
#pragma unroll
        for (int d = 0; d < 4; ++d)
#pragma unroll
            for (int i = 0; i < 16; ++i) xo[crow(i, h_f) * 128 + 32 * d + r_f] = o[d][i];
    }
    __syncthreads();
    if (sub == 0) {
#pragma unroll
        for (int d = 0; d < 4; ++d)
#pragma unroll
            for (int i = 0; i < 16; ++i) { const int a = crow(i, h_f) * 128 + 32 * d + r_f; xo[a] = o[d][i] - xo[a]; }
    }
    __syncthreads();
    if (sub == 0) {
        const int row = lane_f >> 1, half = lane_f & 1;
        const LAS f32x4* src = (const LAS f32x4*)(xo + row * 128 + half * 64);
        f32x4 v[16]; float ss = 0.f;
#pragma unroll
        for (int j = 0; j < 16; ++j) { v[j] = src[j]; ss += (v[j].x * v[j].x + v[j].y * v[j].y) + (v[j].z * v[j].z + v[j].w * v[j].w); }
        ss += __shfl_xor(ss, 1);
        const float rstd = (1.0f / sqrtf(ss * (1.0f / 128.0f) + EPS)) * oscale;
        bf16* dst = mix + (rowbase + (size_t)(qw + row)) * DM + hd * 128 + half * 64;
        const f32x4* gs = (const f32x4*)(subg + half * 64);
#pragma unroll
        for (int j = 0; j < 8; ++j) { const f32x4 a = v[2 * j] * rstd * gs[2 * j], c = v[2 * j + 1] * rstd * gs[2 * j + 1];
            u32x4 w; w.x = pk2(a.x, a.y); w.y = pk2(a.z, a.w); w.z = pk2(c.x, c.y); w.w = pk2(c.z, c.w); *(u32x4*)(dst + 8 * j) = w; }
    }
    __syncthreads();
}
}

typedef unsigned v4u __attribute__((ext_vector_type(4)));
#define XB_TMO      128
#define XB_XCNT(j)  (256  + 64 * (j))
#define XB_XSUB(j)  (1280 + 64 * (j))
#define XB_XGEN(j)  (2304 + 64 * (j))
#define XB_TOP      3328
#define XB_TOPGEN   3392
#define XCD_BAR_WORDS 3456
#define XB_SPIN_CAP (1u << 18)

__device__ __forceinline__ unsigned xb_ld(unsigned* p)              { return __hip_atomic_load(p, __ATOMIC_RELAXED, __HIP_MEMORY_SCOPE_AGENT); }
__device__ __forceinline__ unsigned xb_add(unsigned* p, unsigned v) { return __hip_atomic_fetch_add(p, v, __ATOMIC_RELAXED, __HIP_MEMORY_SCOPE_AGENT); }
__device__ __forceinline__ unsigned xb_xcc_id() { return (unsigned)__builtin_amdgcn_s_getreg((3 << 11) | 20) & 0xFu; }
#define XB_SPIN(cond, bar) do { unsigned _sp = 0; while (cond) { __builtin_amdgcn_s_sleep(1); \
    if ((++_sp & 255u) == 0u) { if (xb_ld(&(bar)[XB_TMO])) break; if (_sp > XB_SPIN_CAP) { atomicAdd(&(bar)[XB_TMO], 1u); break; } } } } while (0)

struct XcdBarrier {
    unsigned* bar; unsigned x;
    volatile LAS unsigned* st;
};

__device__ __forceinline__ XcdBarrier xcd_barrier_post(unsigned* bar, volatile LAS unsigned* st) {
    XcdBarrier b; b.bar = bar; b.x = xb_xcc_id(); b.st = st;
    if (threadIdx.x == 0) (void)xb_add(&bar[XB_XCNT(b.x)], 1u);
    return b;
}
__device__ __forceinline__ void xcd_barrier_complete(unsigned* bar, unsigned x, unsigned& nloc, unsigned& nx) {
    const unsigned G = gridDim.x * gridDim.y * gridDim.z;
    unsigned sum, cnt, mine, sp = 0u;
    for (;;) {
        sum = 0u; cnt = 0u; mine = 0u;
#pragma unroll
        for (unsigned j = 0; j < 16; ++j) { const unsigned c = xb_ld(&bar[XB_XCNT(j)]); sum += c; cnt += (c > 0u) ? 1u : 0u; mine = (j == x) ? c : mine; }
        if (sum == G) break;
        __builtin_amdgcn_s_sleep(1);
        if ((++sp & 255u) == 0u) { if (xb_ld(&bar[XB_TMO])) break; if (sp > XB_SPIN_CAP) { atomicAdd(&bar[XB_TMO], 1u); break; } }
    }
    nloc = mine > 0u ? mine : 1u; nx = cnt > 0u ? cnt : 1u;
}

__device__ __forceinline__ void xcd_barrier(const XcdBarrier& b, const bool lead  ) {
    asm volatile("s_waitcnt vmcnt(0)" ::: "memory");
    __syncthreads();
    if (lead) {
        unsigned* bar = b.bar;
        __builtin_amdgcn_s_waitcnt(0);
        unsigned nloc = b.st[0], nx = b.st[1];
        if (nloc == 0u) { xcd_barrier_complete(bar, b.x, nloc, nx); b.st[0] = nloc; b.st[1] = nx; }
        const unsigned old = xb_add(&bar[XB_XSUB(b.x)], 1u);
        const unsigned gen = old / nloc;
        if (old + 1u == (gen + 1u) * nloc) {
            __builtin_amdgcn_fence(__ATOMIC_RELEASE, "agent");
            asm volatile("s_waitcnt vmcnt(0)" ::: "memory");
            const unsigned og = xb_add(&bar[XB_TOP], 1u);
            const unsigned tg = og / nx;
            if (og + 1u == (tg + 1u) * nx) xb_add(&bar[XB_TOPGEN], 1u);
            else XB_SPIN(xb_ld(&bar[XB_TOPGEN]) == tg, bar);
            __builtin_amdgcn_fence(__ATOMIC_ACQUIRE, "agent");
            xb_add(&bar[XB_XGEN(b.x)], 1u);
            asm volatile("s_waitcnt vmcnt(0)" ::: "memory");
        } else {
            XB_SPIN(xb_ld(&bar[XB_XGEN(b.x)]) == gen, bar);
            __builtin_amdgcn_fence(__ATOMIC_ACQUIRE, "agent");
            asm volatile("s_waitcnt vmcnt(0)" ::: "memory");
        }
    }
    __syncthreads();
}

#define XL_RANK(j) (3520 + 64 * (j))
#define XL_SUB(j)  (4608 + 64 * (j))
#define XL_GEN(j)  (5696 + 64 * (j))
constexpr int CTL_ZERO_BYTES = 32768;
__device__ __forceinline__ void xcd_local_barrier(unsigned* bar, unsigned x, unsigned nloc, const bool lead, volatile LAS unsigned* genw  ) {
    asm volatile("s_waitcnt vmcnt(0)" ::: "memory");
    __syncthreads();
    if (lead) {
        __builtin_amdgcn_s_waitcnt(0);
        const unsigned gen = genw[0]; genw[0] = gen + 1u;
        const unsigned old = xb_add(&bar[XL_SUB(x)], 1u);
        if (old + 1u == (gen + 1u) * nloc) xb_add(&bar[XL_GEN(x)], 1u);
        else XB_SPIN(xb_ld(&bar[XL_GEN(x)]) == gen, bar);
        __builtin_amdgcn_fence(__ATOMIC_ACQUIRE, "agent");
        asm volatile("s_waitcnt vmcnt(0)" ::: "memory");
    }
    __syncthreads();
}

__global__ void __launch_bounds__(NTHR, 2) fwd_kernel(Args A_by_value) {
    KArgs Ap0 = (KArgs)__builtin_amdgcn_kernarg_segment_ptr();
#define A (*Ap)
    KArgs Ap = Ap0;
    extern __shared__ __attribute__((aligned(16))) unsigned char lds_raw[];
    LAS unsigned char* lds = (LAS unsigned char*)lds_raw;
    cg::grid_group grid = cg::this_grid();
    const int wave0 = __builtin_amdgcn_readfirstlane((int)threadIdx.x >> 6);
    volatile LAS unsigned* MISC = (volatile LAS unsigned*)(lds + 131072);
    if (threadIdx.x < 64) MISC[threadIdx.x] = 0u;
    __syncthreads();
    const XcdBarrier bar = xcd_barrier_post((unsigned*)A.ws, MISC + 8);
    if (threadIdx.x == 0) { MISC[16] = xb_add(&((unsigned*)A.ws)[XL_RANK(bar.x)], 1u); MISC[17] = 0u; MISC[18] = 0u; }
    __syncthreads();
    int ph = A.ph_lo, rep = 0;
    while (ph < A.ph_hi) {
#if PROBE
        int ptype; if (ph == 0) ptype = 0; else if (ph == 1) ptype = 1; else { const int s_ = (ph - 2) % 7, l_ = (ph - 2) / 7; ptype = (s_ == 0 || s_ == 5) ? 2 : (s_ == 2 ? 3 : ((s_ == 1 || s_ == 6) ? 4 : (s_ == 4 ? 5 : ((l_ & 1) ? 7 : 9)))); }
        const int nrep = 1 + ((PROBE >> ptype) & 1);
#else
        const int nrep = 1;
#endif
        Ap = Ap0; asm volatile("" : "+s"(Ap));
#define tid fresh_tid(wave0)
#define lane (fresh_tid(wave0) & 63)
#define wave wave0
        const int G = gridDim.x;
        if (ph >= 2 && (unsigned)__builtin_amdgcn_readfirstlane((int)MISC[17]) == 0u) {
            if (fresh_tid(wave0) == 0) { unsigned ok = (G % 8 == 0) ? 1u : 0u;
                for (unsigned j = 0; j < 16; ++j) { const unsigned c = xb_ld(&((unsigned*)A.ws)[XL_RANK(j)]); if (c != (j < 8 ? (unsigned)G >> 3 : 0u)) ok = 0u; }
                MISC[17] = ok ? 1u : 2u; }
            __syncthreads();
        }
        const bool teamed = (ph >= 2) && (unsigned)__builtin_amdgcn_readfirstlane((int)MISC[17]) == 1u;
        const int vc = teamed ? (int)((unsigned)__builtin_amdgcn_readfirstlane((int)MISC[16]) * 8u + bar.x) : (int)blockIdx.x;
        unsigned char* ws = A.ws; asm volatile("" : "+s"(ws));
        float* const mod = (float*)(ws + WS_MOD);
        bf16* const Hb = (bf16*)(ws + WS_H); bf16* const MIXb = (bf16*)(ws + WS_MIX); bf16* const ACTb = (bf16*)(ws + WS_ACT);
        float* const rowss = (float*)(ws + WS_ROWSS);
        if (ph == 0) { prep_phase(Ap, lds, tid, lane, wave); }
        else if (ph == 1) { prep2_phase(Ap, lane, wave); }
        else {
            const int l = (ph - 2) / 7, s = (ph - 2) % 7, e = l >> 1;
            const float* modl = mod + (size_t)l * 2 * NMOD;
            const float* xcur = (ph <= 3) ? A.in[0] : A.out;
            const float* biasl = (const float*)(ws + WS_BIAS) + (size_t)l * BIAS_L;
            if (s == 0 || s == 5 || s == 2) {
                const bf16* W; int N, ldc, pn0, colbase, act, qkn = 0; const float* bias;
                if (s != 2) { W = (const bf16*)(ws + WS_WGU) + (size_t)(l * 2 + (s == 0 ? 0 : 1)) * 5632 * 1024; N = 5632; ldc = FF; pn0 = 0; colbase = 0; act = 1; bias = biasl + (s == 0 ? 0 : BIAS_F2); }
                else if ((l & 1) == 0) { W = (const bf16*)(ws + WS_WINAB) + (size_t)e * 2048 * 1024; N = 2048; ldc = 2048; pn0 = 8; colbase = 0; act = 0; bias = biasl + BIAS_MIX; qkn = 1; }
                else { W = (const bf16*)(ws + WS_WINC) + (size_t)e * 3072 * 1024; N = 3072; ldc = 2048; pn0 = 4; colbase = 1024; act = 0; bias = biasl + BIAS_MIX; }
                pg8::Gemm g{Hb, W, M, N, DM, (PROBE_BLIN && rep + 1 < nrep) ? 1 : 0}; pg8::StaticOrder S; S.init(M, N, G, vc);
                LAS unsigned* EP = (LAS unsigned*)(lds + 131072 + 256);
                if (tid == 0) pg8::EpiMix::put(EP, ACTb, ldc, pn0, colbase, act, rowss, bias, N, qkn, A.in[9] + e * 128);
                { LAS float* BC = (LAS float*)(lds + 131072 + (qkn ? 1024 : 4096)); pg8::Unit uu; const int t_ = tid;
                  for (int i = 0; S.next(i, uu); ++i) if (t_ < 256) BC[i * 256 + t_] = bias[(size_t)((uu.pm * 256) / SEQ) * N + uu.pn * 256 + t_]; }
                __syncthreads();
                pg8::EpiMix E{EP};
                pg8::gemm_phase<pg8::EpiMix, pg8::StaticOrder, true, true>(lds, g, S, E, tid);
            } else if (s == 1 || s == 6 || s == 4) {
                const bf16* Ain; const bf16* W; int K; const float* gate; float gs;
                if (s != 4) { Ain = ACTb; W = (const bf16*)(ws + WS_WD) + (size_t)(l * 2 + (s == 1 ? 0 : 1)) * 1024 * FF; K = FF; gate = modl + (s == 1 ? 2 : 8) * DM; gs = 0.5f; }
                else { Ain = MIXb; W = ((l & 1) == 0 ? (const bf16*)(ws + WS_WOUTAB) : (const bf16*)(ws + WS_WOUTC)) + (size_t)e * DM * DM; K = DM; gate = modl + 5 * DM; gs = 1.0f; }
                const int nl = (s == 6) ? l + 1 : l, nj = (s == 1) ? 1 : (s == 4 ? 2 : 0);
                const int has_nxt = nl < 4, nlc = has_nxt ? nl : 3;
                const float* ng = A.in[2] + (size_t)(nlc * 3 + nj) * DM;
                const float* nsc = mod + (size_t)nlc * 2 * NMOD + (3 * nj + 1) * DM;
                pg8::Gemm g{Ain, W, M, DM, K, 0}; pg8::StaticOrder S; S.init(M, DM, G, vc);
                LAS unsigned* EP = (LAS unsigned*)(lds + 131072 + 256);
                if (tid == 0) pg8::EpiRes::put(EP, xcur, A.out, gate, (rep + 1 < nrep) ? 0.0f : gs, ng, nsc, Hb, rowss, has_nxt);
                __syncthreads();
                pg8::EpiRes E{EP};
                pg8::gemm_phase<pg8::EpiRes, pg8::StaticOrder, true, true>(lds, g, S, E, tid);
            } else {
                if ((l & 1) == 0) {
                    for (int rp = 0; rp < 1 + ((PROBE >> 6) & 1); ++rp) pool_phase(ACTb, MIXb, lane, wave);
                    const float* lq1 = A.in[10] + e * 64; const float* lk1 = A.in[11] + e * 64; const float* lq2 = A.in[12] + e * 64; const float* lk2 = A.in[13] + e * 64;
                    float s1 = 0.f, s2 = 0.f;
                    for (int i = 0; i < 64; ++i) { s1 += lq1[i] * lk1[i]; s2 += lq2[i] * lk2[i]; }
                    const float lam_init = 0.8f - 0.6f * expf(-0.3f * (float)l);
                    const float lam = expf(s1) - expf(s2) + lam_init;
                    for (int ui = 0; ui < 2; ++ui) {
                        for (int v0 = vc; v0 < 256; v0 += G) {
                            const int v = (G == 256) ? (v0 & 7) * 32 + (v0 >> 3) : v0;
                            const int bh = v >> 5, x = v & 31, qb = ui == 0 ? 63 - x : x;
#if PROBE_ATT
                            att::attn_unit<PROBE_ATT>(lds, ACTb, ACTb, MIXb, bh >> 2, bh & 3, qb, A.in[14] + e * 128, lam, 1.0f - lam_init, tid);
#endif
                            att::attn_unit<0>(lds, ACTb, ACTb, MIXb, bh >> 2, bh & 3, qb, A.in[14] + e * 128, lam, 1.0f - lam_init, tid);
                        }
                    }
                } else conv_phase(ACTb, MIXb, A.in[19] + (size_t)e * 3 * DM, tid);
            }
        }
        if (ph >= 1 && ph + 1 < A.ph_hi && !PROBE) {
            const int np = ph + 1 - 2, nl_ = np / 7, ns_ = np % 7, ne_ = nl_ >> 1; unsigned wo_ = 0u; int nN = 0, nK = DM;
            if (ns_ == 0 || ns_ == 5) { wo_ = (unsigned)WS_WGU + (unsigned)(nl_ * 2 + (ns_ == 0 ? 0 : 1)) * (5632u * 1024u * 2u); nN = 5632; }
            else if (ns_ == 2) { if ((nl_ & 1) == 0) { wo_ = (unsigned)WS_WINAB + (unsigned)ne_ * (2048u * 1024u * 2u); nN = 2048; } else { wo_ = (unsigned)WS_WINC + (unsigned)ne_ * (3072u * 1024u * 2u); nN = 3072; } }
            else if (ns_ == 1 || ns_ == 6) { wo_ = (unsigned)WS_WD + (unsigned)(nl_ * 2 + (ns_ == 1 ? 0 : 1)) * (1024u * (unsigned)FF * 2u); nN = DM; nK = FF; }
            else if (ns_ == 4) { wo_ = ((nl_ & 1) == 0 ? (unsigned)WS_WOUTAB : (unsigned)WS_WOUTC) + (unsigned)ne_ * (unsigned)(DM * DM * 2); nN = DM; }
            if (nN) { const int t_ = tid, npn = vc >> 6;
                const unsigned char* wp_ = ws + wo_ + ((size_t)(npn * 256 + (t_ >> 1)) * (size_t)nK) * 2 + (size_t)(t_ & 1) * 128;
                const unsigned pv_ = *(const volatile unsigned*)wp_; asm volatile("" :: "v"(pv_)); }
        }
        if (ph + 1 < A.ph_hi || rep + 1 < nrep) {
            const int s_ = (ph >= 2) ? (ph - 2) % 7 : -1;
            if (A.ph_hi > 1000000) grid.sync();
            else if (teamed && !PROBE && (s_ == 0 || s_ == 1 || s_ == 4 || s_ == 5 || s_ == 6)) xcd_local_barrier(bar.bar, bar.x, (unsigned)G >> 3, fresh_tid(wave0) == 0, MISC + 18);
            else xcd_barrier(bar, fresh_tid(wave0) == 0);
        }
        if (rep + 1 < nrep) ++rep; else { rep = 0; ++ph; }
    }
}

#ifndef PROBE
#define PROBE 0
#endif
#undef tid
#undef lane
#undef wave
#undef A
#ifndef N_LAUNCH_MODE
#define N_LAUNCH_MODE 1
#endif
extern "C" void kernel_launch(void* const* d_in, const int* in_sizes, int n_in, void* d_out, int out_size, void* d_ws, size_t ws_size, hipStream_t stream) {
    static int grid = 0;
    if (grid == 0) {
        if (n_in != 21 || out_size != M * DM || ws_size < WS_END) { fprintf(stderr, "kernel_launch: unexpected problem (n_in %d out %d ws %zu)\n", n_in, out_size, ws_size); grid = -1; return; }
        int dev = 0, cus = 0, per_cu = 0;
        hipGetDevice(&dev); hipDeviceGetAttribute(&cus, hipDeviceAttributeMultiprocessorCount, dev);
        if (hipFuncSetAttribute((const void*)fwd_kernel, hipFuncAttributeMaxDynamicSharedMemorySize, LDS_BYTES) != hipSuccess) { fprintf(stderr, "kernel_launch: hipFuncSetAttribute failed\n"); grid = -1; return; }
        if (hipOccupancyMaxActiveBlocksPerMultiprocessor(&per_cu, (const void*)fwd_kernel, NTHR, LDS_BYTES) != hipSuccess || per_cu < 1) { fprintf(stderr, "kernel_launch: occupancy query says %d\n", per_cu); per_cu = 1; }
        (void)hipGetLastError();
        grid = cus * 1;
    }
    if (grid < 0) return;
    if (hipMemsetAsync(d_ws, 0, CTL_ZERO_BYTES, stream) != hipSuccess) { fprintf(stderr, "kernel_launch: memset of the barrier words failed\n"); return; }
    Args a{};
    for (int i = 0; i < 21; ++i) a.in[i] = (const float*)d_in[i];
    a.out = (float*)d_out; a.ws = (unsigned char*)d_ws;
    constexpr int NPH = 30;
#if N_LAUNCH_MODE == 0
    for (int ph = 0; ph < NPH; ++ph) { a.ph_lo = ph; a.ph_hi = ph + 1; hipLaunchKernelGGL(fwd_kernel, dim3(grid), dim3(NTHR), LDS_BYTES, stream, a); }
#else
    a.ph_lo = 0; a.ph_hi = NPH;
    void* args[] = {&a};
    hipError_t e = hipLaunchCooperativeKernel((const void*)fwd_kernel, dim3(grid), dim3(NTHR), args, LDS_BYTES, stream);
    if (e != hipSuccess) fprintf(stderr, "cooperative launch failed: %s (grid %d)\n", hipGetErrorString(e), grid);
#endif
}
```
